# Optimizing an MI355X kernel written in HIP

```python
import jax, jax.numpy as jnp
from jax import lax
import numpy as np

D_MODEL = 2048
BATCH = 16
SEQ = 256
DEPTH = 2
DEC_BATCH = 8
DEC_SEQ = 1024
PAST_LEN = 256

GRID_W = 64
HEAD_DIM = 64
MIX_WIDTH = D_MODEL
BRANCH_W = MIX_WIDTH // 4
FOURIER_GROUPS = 8
FOURIER_GROUP_W = BRANCH_W // FOURIER_GROUPS
HYENA_W = BRANCH_W
SHORT_CONV = 3
FILTER_FREQS = 16
FILTER_FEATS = 1 + 2 * FILTER_FREQS
FILTER_HIDDEN = 64
DECAY_SHIFT = 0.05
N_HEADS = BRANCH_W // HEAD_DIM
N_KV_HEADS = 2
KV_W = N_KV_HEADS * HEAD_DIM
WINDOW = 128
BLOCK = 128
ROPE_THETA = 10000.0
ALPHA = (2 * DEPTH) ** 0.25
BETA = (8 * DEPTH) ** -0.25
LN_EPS = 1e-5
RMS_EPS = 1e-6
NEG_INF = -1e30
IN_SIZES = (BRANCH_W, BRANCH_W, 3 * HYENA_W, HYENA_W,
            BRANCH_W, KV_W, KV_W, BRANCH_W,
            BRANCH_W, KV_W, KV_W, BRANCH_W)
IN_WIDTH = sum(IN_SIZES)

kernel_name = 'hybrid_fourier_hyena_swa_gqa_prefix_dit'

F32 = jnp.float32


def split_points(sizes):
    pts, acc = [], 0
    for s in sizes[:-1]:
        acc += s
        pts.append(acc)
    return pts


def layer_norm(x, g=None, b=None):
    xf = x.astype(F32)
    mu = jnp.mean(xf, -1, keepdims=True)
    var = jnp.mean(jnp.square(xf - mu), -1, keepdims=True)
    y = (xf - mu) * lax.rsqrt(var + LN_EPS)
    if g is not None:
        y = y * g.astype(F32) + b.astype(F32)
    return y.astype(x.dtype)


def rms_norm(x, g):
    xf = x.astype(F32)
    y = xf * lax.rsqrt(jnp.mean(xf * xf, -1, keepdims=True) + RMS_EPS) * g.astype(F32)
    return y.astype(x.dtype)


def axial_rope_angles(seq_len):
    rows = seq_len // GRID_W
    row = jnp.repeat(jnp.arange(rows, dtype=F32), GRID_W)
    col = jnp.tile(jnp.arange(GRID_W, dtype=F32), rows)
    half = HEAD_DIM // 2
    inv = ROPE_THETA ** (-jnp.arange(0, half, 2, dtype=F32) / half)
    return row[:, None] * inv, col[:, None] * inv


def rotate(x, ang):
    m = ang.shape[-1]
    cos = jnp.cos(ang)[None, :, None, :].astype(x.dtype)
    sin = jnp.sin(ang)[None, :, None, :].astype(x.dtype)
    x1, x2 = x[..., :m], x[..., m:]
    return jnp.concatenate([x1 * cos - x2 * sin, x2 * cos + x1 * sin], -1)


def axial_rope(x, ang_row, ang_col):
    half = HEAD_DIM // 2
    return jnp.concatenate([rotate(x[..., :half], ang_row), rotate(x[..., half:], ang_col)], -1)


def modulation(cond, w_ada, b_ada):
    m = jax.nn.silu(cond) @ w_ada + b_ada
    shift, scale, gate = jnp.split(m, 3, axis=-1)
    return shift[:, None, :], scale[:, None, :], gate[:, None, :]


def fourier_mix(a, w_f):
    b, l, _ = a.shape
    a4 = a.reshape(b, l, FOURIER_GROUPS, FOURIER_GROUP_W).astype(F32)
    f = jnp.fft.fft2(a4, axes=(1, 3), norm='ortho').real
    return f.reshape(b, l, BRANCH_W).astype(a.dtype) @ w_f


def short_conv3(u, w, b):
    up = jnp.pad(u, ((0, 0), (1, 1), (0, 0)))
    return up[:, :-2] * w[0] + up[:, 1:-1] * w[1] + up[:, 2:] * w[2] + b


def hyena_filters(seq_len, w1, b1, w2, b2, w3, log_decay):
    t = jnp.arange(seq_len, dtype=F32)
    tn = t / seq_len
    freqs = jnp.arange(1, FILTER_FREQS + 1, dtype=F32)
    ang = 2.0 * jnp.pi * tn[:, None] * freqs[None, :]
    feats = jnp.concatenate([tn[:, None], jnp.cos(ang), jnp.sin(ang)], -1)
    h = jnp.sin(feats @ w1.astype(F32) + b1.astype(F32))
    h = jnp.sin(h @ w2.astype(F32) + b2.astype(F32))
    h = h @ w3.astype(F32)
    dist = jnp.abs(t - seq_len // 2) / (seq_len / 2)
    window = jnp.exp(-dist[:, None] * jnp.exp(log_decay.astype(F32))[None, :]) + DECAY_SHIFT
    h = h * window
    return h * lax.rsqrt(jnp.sum(h * h, 0, keepdims=True) + RMS_EPS)


def long_conv(u, h, skip):
    l = u.shape[1]
    n = 2 * l
    c0 = l // 2
    uf = jnp.fft.rfft(u.astype(F32), n=n, axis=1)
    hf = jnp.fft.rfft(h, n=n, axis=0)
    z = jnp.fft.irfft(uf * hf[None], n=n, axis=1)[:, c0:c0 + l]
    return (z + u.astype(F32) * skip.astype(F32)).astype(u.dtype)


def hyena_mix(u, conv_w, conv_b, fw1, fb1, fw2, fb2, fw3, log_decay, skip):
    u = short_conv3(u, conv_w, conv_b)
    v, x1, x2 = jnp.split(u, 3, axis=-1)
    filt = hyena_filters(u.shape[1], fw1, fb1, fw2, fb2, fw3, log_decay)
    z = x1 * long_conv(v, filt[:, :HYENA_W], skip[:HYENA_W])
    return x2 * long_conv(z, filt[:, HYENA_W:], skip[HYENA_W:])


def to_heads(x, n):
    return x.reshape(x.shape[0], x.shape[1], n, HEAD_DIM)


def dense_block_attention(q, k, v, sink):
    b, lq, h, d = q.shape
    kvh = k.shape[2]
    g = h // kvh
    nb = lq // BLOCK
    lk = k.shape[1]
    scale = d ** -0.5
    qb = q.reshape(b, nb, BLOCK, kvh, g, d).swapaxes(0, 1)

    def one_block(qblk):
        s = jnp.einsum('bqkgd,bskd->bkgqs', qblk, k, preferred_element_type=F32) * scale
        if sink is not None:
            sk = jnp.broadcast_to(sink.astype(F32).reshape(kvh, g)[None, :, :, None, None],
                                  s.shape[:-1] + (1,))
            s = jnp.concatenate([s, sk], -1)
        w = jax.nn.softmax(s, axis=-1)[..., :lk]
        return jnp.einsum('bkgqs,bskd->bqkgd', w.astype(v.dtype), v)

    o = lax.map(one_block, qb)
    return o.swapaxes(0, 1).reshape(b, lq, h * d)


def windowed_attention(q, k, v, k_ctx, v_ctx, sink):
    b, l, h, d = q.shape
    kvh = k.shape[2]
    g = h // kvh
    nb = l // BLOCK
    span = BLOCK + 2 * WINDOW
    lc = k_ctx.shape[1]
    scale = d ** -0.5
    pad = ((0, 0), (WINDOW, WINDOW), (0, 0), (0, 0))
    idx = jnp.arange(nb)[:, None] * BLOCK + jnp.arange(span)[None, :]
    kb = jnp.pad(k, pad)[:, idx]
    vb = jnp.pad(v, pad)[:, idx]
    qb = q.reshape(b, nb, BLOCK, kvh, g, d)
    s_loc = jnp.einsum('bnqkgd,bnskd->bnkgqs', qb, kb, preferred_element_type=F32) * scale
    qpos = jnp.arange(nb)[:, None, None] * BLOCK + jnp.arange(BLOCK)[None, :, None]
    kpos = jnp.arange(nb)[:, None, None] * BLOCK + jnp.arange(span)[None, None, :] - WINDOW
    valid = (jnp.abs(kpos - qpos) <= WINDOW) & (kpos >= 0) & (kpos < l)
    s_loc = jnp.where(valid[None, :, None, None], s_loc, NEG_INF)
    s_ctx = jnp.einsum('bnqkgd,bckd->bnkgqc', qb, k_ctx.astype(qb.dtype), preferred_element_type=F32) * scale
    s_sink = jnp.broadcast_to(sink.astype(F32).reshape(kvh, g)[None, None, :, :, None, None],
                              s_loc.shape[:-1] + (1,))
    w = jax.nn.softmax(jnp.concatenate([s_loc, s_ctx, s_sink], -1), axis=-1).astype(v.dtype)
    o = (jnp.einsum('bnkgqs,bnskd->bnqkgd', w[..., :span], vb)
         + jnp.einsum('bnkgqc,bckd->bnqkgd', w[..., span:span + lc], v_ctx.astype(v.dtype)))
    return o.reshape(b, l, h * d)


def trunk_layer(x, mod, p, ctx_kv=None, rope=None):
    shift, scale, gate = mod
    hmod = layer_norm(x) * (1 + scale) + shift
    parts = jnp.split(hmod @ p['w_in'], split_points(IN_SIZES), axis=-1)
    a_in, a_g, b_in, b_g, cq, ck, cv, c_g, dq, dk, dv, d_g = parts
    y_a = fourier_mix(a_in, p['w_fourier']) * jax.nn.silu(a_g)
    y_b = hyena_mix(b_in, p['conv_w'], p['conv_b'], p['filt_w1'], p['filt_b1'], p['filt_w2'],
                    p['filt_b2'], p['filt_w3'], p['filt_log_decay'], p['hyena_skip']) * jax.nn.silu(b_g)
    cq, ck, cv = to_heads(cq, N_HEADS), to_heads(ck, N_KV_HEADS), to_heads(cv, N_KV_HEADS)
    dq = rms_norm(to_heads(dq, N_HEADS), p['q_norm'])
    dk = rms_norm(to_heads(dk, N_KV_HEADS), p['k_norm'])
    dv = to_heads(dv, N_KV_HEADS)
    if ctx_kv is None:
        o_c = dense_block_attention(cq, ck, cv, p['sink'])
        o_d = dense_block_attention(dq, dk, dv, None)
        new_kv = (ck, cv, dk, dv)
    else:
        ang_r, ang_c = rope
        kc_ctx, vc_ctx, kd_ctx, vd_ctx = ctx_kv
        o_c = windowed_attention(axial_rope(cq, ang_r, ang_c), axial_rope(ck, ang_r, ang_c), cv,
                                 kc_ctx, vc_ctx, p['sink'])
        k_all = jnp.concatenate([axial_rope(dk, ang_r, ang_c), kd_ctx.astype(dk.dtype)], axis=1)
        v_all = jnp.concatenate([dv, vd_ctx.astype(dv.dtype)], axis=1)
        o_d = dense_block_attention(axial_rope(dq, ang_r, ang_c), k_all, v_all, None)
        new_kv = None
    y = jnp.concatenate([y_a, y_b, o_c * jax.nn.silu(c_g), o_d * jax.nn.silu(d_g)], -1) @ p['w_out']
    x = layer_norm(ALPHA * x + gate * y, p['ln_g'], p['ln_b'])
    return x, new_kv


def setup_inputs(seed: int = 0) -> dict:
    key = jax.random.key(seed)
    ks = jax.random.split(key, 28)

    def nrm(k, shape, s):
        return jax.random.normal(k, shape, F32) * s

    cache_shape = (DEC_BATCH, DEPTH, PAST_LEN, N_KV_HEADS, HEAD_DIM)
    base_decay = jnp.log(jnp.linspace(3.0, 15.0, 2 * HYENA_W, dtype=F32))
    return {
        'x_prompt': nrm(ks[0], (BATCH, SEQ, D_MODEL), 1.0),
        'x_sample': nrm(ks[1], (DEC_BATCH, DEC_SEQ, D_MODEL), 1.0),
        'cache_attn_c_k': nrm(ks[2], cache_shape, 1.0),
        'cache_attn_c_v': nrm(ks[3], cache_shape, 1.0),
        'cache_attn_d_k': nrm(ks[4], cache_shape, 1.0),
        'cache_attn_d_v': nrm(ks[5], cache_shape, 1.0),
        'c': nrm(ks[6], (DEC_BATCH, D_MODEL), 1.0),
        'c_ctx': nrm(ks[7], (D_MODEL,), 1.0),
        'w_ada': nrm(ks[8], (DEPTH, D_MODEL, 3 * D_MODEL), 0.5 * D_MODEL ** -0.5),
        'b_ada': nrm(ks[9], (DEPTH, 3 * D_MODEL), 0.01),
        'w_in': nrm(ks[10], (DEPTH, D_MODEL, IN_WIDTH), D_MODEL ** -0.5),
        'w_fourier': nrm(ks[11], (DEPTH, BRANCH_W, BRANCH_W), BRANCH_W ** -0.5),
        'conv_w': nrm(ks[12], (DEPTH, SHORT_CONV, 3 * HYENA_W), SHORT_CONV ** -0.5),
        'conv_b': nrm(ks[13], (DEPTH, 3 * HYENA_W), 0.01),
        'filt_w1': nrm(ks[14], (DEPTH, FILTER_FEATS, FILTER_HIDDEN), 1.0),
        'filt_b1': nrm(ks[15], (DEPTH, FILTER_HIDDEN), 0.5),
        'filt_w2': nrm(ks[16], (DEPTH, FILTER_HIDDEN, FILTER_HIDDEN), FILTER_HIDDEN ** -0.5),
        'filt_b2': nrm(ks[17], (DEPTH, FILTER_HIDDEN), 0.5),
        'filt_w3': nrm(ks[18], (DEPTH, FILTER_HIDDEN, 2 * HYENA_W), FILTER_HIDDEN ** -0.5),
        'filt_log_decay': base_decay[None, :] + nrm(ks[19], (DEPTH, 2 * HYENA_W), 0.01),
        'hyena_skip': nrm(ks[20], (DEPTH, 2 * HYENA_W), 0.5),
        'sink_logit': nrm(ks[21], (DEPTH, N_HEADS), 0.5),
        'q_norm': 1.0 + nrm(ks[22], (DEPTH, HEAD_DIM), 0.01),
        'k_norm': 1.0 + nrm(ks[23], (DEPTH, HEAD_DIM), 0.01),
        'w_out': nrm(ks[24], (DEPTH, MIX_WIDTH, D_MODEL), BETA * MIX_WIDTH ** -0.5),
        'ln_g': 1.0 + nrm(ks[25], (DEPTH, D_MODEL), 0.01),
        'ln_b': nrm(ks[26], (DEPTH, D_MODEL), 0.01),
    }


def reference(x_prompt, x_sample, cache_attn_c_k, cache_attn_c_v, cache_attn_d_k, cache_attn_d_v,
              c, c_ctx, w_ada, b_ada, w_in, w_fourier, conv_w, conv_b, filt_w1, filt_b1, filt_w2,
              filt_b2, filt_w3, filt_log_decay, hyena_skip, sink_logit, q_norm, k_norm, w_out,
              ln_g, ln_b):
    rope = axial_rope_angles(x_sample.shape[1])
    y_p, y_s = x_prompt, x_sample
    kc_list, vc_list, kd_list, vd_list = [], [], [], []
    for l in range(DEPTH):
        p = {
            'w_in': w_in[l], 'w_fourier': w_fourier[l], 'conv_w': conv_w[l], 'conv_b': conv_b[l],
            'filt_w1': filt_w1[l], 'filt_b1': filt_b1[l], 'filt_w2': filt_w2[l],
            'filt_b2': filt_b2[l], 'filt_w3': filt_w3[l], 'filt_log_decay': filt_log_decay[l],
            'hyena_skip': hyena_skip[l], 'sink': sink_logit[l], 'q_norm': q_norm[l],
            'k_norm': k_norm[l], 'w_out': w_out[l], 'ln_g': ln_g[l], 'ln_b': ln_b[l],
        }
        mod_ctx = modulation(c_ctx[None, :], w_ada[l], b_ada[l])
        mod_lat = modulation(c, w_ada[l], b_ada[l])
        y_p, kv = trunk_layer(y_p, mod_ctx, p)
        kc_list.append(kv[0])
        vc_list.append(kv[1])
        kd_list.append(kv[2])
        vd_list.append(kv[3])
        ctx_kv = (cache_attn_c_k[:, l], cache_attn_c_v[:, l], cache_attn_d_k[:, l], cache_attn_d_v[:, l])
        y_s, _ = trunk_layer(y_s, mod_lat, p, ctx_kv=ctx_kv, rope=rope)
    new_c_k = jnp.stack(kc_list, axis=1)
    new_c_v = jnp.stack(vc_list, axis=1)
    new_d_k = jnp.stack(kd_list, axis=1)
    new_d_v = jnp.stack(vd_list, axis=1)
    return (y_p, y_s, new_c_k, new_c_v, new_d_k, new_d_v)
```

```cpp
#include <hip/hip_runtime.h>
#include <hip/hip_cooperative_groups.h>
#include <cstdio>
#include <cstring>
namespace cg = cooperative_groups;

#ifndef SINGLE_LAUNCH
#define SINGLE_LAUNCH 1
#endif
#ifndef DMASK
#define DMASK 15
#endif
#ifndef DUP
#define DUP 0
#endif
#ifndef PM
#define PM 0xffff
#endif

typedef __attribute__((ext_vector_type(8))) short bf16x8;
typedef __attribute__((ext_vector_type(4))) float f32x4;
typedef unsigned short u16;
typedef unsigned u32x4 __attribute__((ext_vector_type(4)));
typedef unsigned u32x2 __attribute__((ext_vector_type(2)));

#define NTOK 12288
#define NCTX 4096
#define DM 2048
#define NIN 6144
#define OUT_KV 25165824
#define KVSZ 1048576
#define NPHASE 10
#define MIX_ITEMS 2944

struct Params {
  const float *x_prompt, *x_sample, *cck, *ccv, *cdk, *cdv, *c, *c_ctx, *w_ada, *b_ada, *w_in, *w_f,
      *conv_w, *conv_b, *fw1, *fb1, *fw2, *fb2, *fw3, *log_decay, *skip, *sink, *q_norm, *k_norm,
      *w_out, *ln_g, *ln_b;
  float* out;
  u16 *WinT, *WoutT, *WAbf, *M2T, *FR, *DFT1024, *DFT256, *KL, *VtL, *KC, *VtC, *hmod, *G, *UT, *BT, *QB;
  float *mod, *h2, *rope, *R;
  unsigned* ctr;
  unsigned* bar;
  int phase_lo, phase_hi;
};

typedef __attribute__((ext_vector_type(2))) __bf16 bf16x2_t;
typedef __attribute__((ext_vector_type(2))) float f32x2_t;
__device__ __forceinline__ unsigned pack2(float a, float b) {
  const bf16x2_t v = __builtin_convertvector(f32x2_t{a, b}, bf16x2_t);
  return __builtin_bit_cast(unsigned, v);
}
__device__ __forceinline__ u16 f2bf(float f) {
  unsigned u = __float_as_uint(f);
  u += 0x7fffu + ((u >> 16) & 1u);
  return (u16)(u >> 16);
}
__device__ __forceinline__ float bf2f(u16 h) { return __uint_as_float(((unsigned)h) << 16); }
__device__ __forceinline__ float silu_f(float x) { return x / (1.0f + __expf(-x)); }
__device__ __forceinline__ float wave_sum(float v) {
#pragma unroll
  for (int o = 32; o > 0; o >>= 1) v += __shfl_xor(v, o);
  return v;
}
__device__ __forceinline__ int otid() { int t = threadIdx.x; asm volatile("" : "+v"(t)); return t; }
#define MFMA(a, b, c) __builtin_amdgcn_mfma_f32_16x16x32_bf16(a, b, c, 0, 0, 0)


#define XB_TMO      128
#define XB_XCNT(j)  (256  + 64 * (j))
#define XB_XSUB(j)  (1280 + 64 * (j))
#define XB_XGEN(j)  (2304 + 64 * (j))
#define XB_TOP      3328
#define XB_TOPGEN   3392
#define XCD_BAR_WORDS 3456
#define XB_SPIN_CAP (1u << 22)
#define LAS __attribute__((address_space(3)))
__device__ __forceinline__ unsigned xb_ld(unsigned* p) { return __hip_atomic_load(p, __ATOMIC_RELAXED, __HIP_MEMORY_SCOPE_AGENT); }
__device__ __forceinline__ unsigned xb_add(unsigned* p, unsigned v) { return __hip_atomic_fetch_add(p, v, __ATOMIC_RELAXED, __HIP_MEMORY_SCOPE_AGENT); }
__device__ __forceinline__ unsigned xb_xcc_id() { return (unsigned)__builtin_amdgcn_s_getreg((3 << 11) | 20) & 0xFu; }
#define XB_SPIN(cond, bar) do { unsigned _sp = 0; while (cond) { __builtin_amdgcn_s_sleep(1); \
    if ((++_sp & 255u) == 0u) { if (xb_ld(&(bar)[XB_TMO])) break; if (_sp > XB_SPIN_CAP) { atomicAdd(&(bar)[XB_TMO], 1u); break; } } } } while (0)
struct XcdBarrier { unsigned* bar; unsigned x; volatile LAS unsigned* st; };
__device__ __forceinline__ XcdBarrier xcd_barrier_post(unsigned* bar, volatile LAS unsigned* st) {
  XcdBarrier b; b.bar = bar; b.x = xb_xcc_id(); b.st = st;
  if (threadIdx.x == 0) (void)xb_add(&bar[XB_XCNT(b.x)], 1u);
  return b;
}
__device__ __forceinline__ void xcd_barrier_complete(unsigned* bar, unsigned x, unsigned& nloc, unsigned& nx) {
  const unsigned G = gridDim.x * gridDim.y * gridDim.z;
  unsigned sum, cnt, mine, sp = 0u;
  for (;;) {
    sum = 0u; cnt = 0u; mine = 0u;
#pragma unroll
    for (unsigned j = 0; j < 16; ++j) { const unsigned c = xb_ld(&bar[XB_XCNT(j)]); sum += c; cnt += (c > 0u) ? 1u : 0u; mine = (j == x) ? c : mine; }
    if (sum == G) break;
    __builtin_amdgcn_s_sleep(1);
    if ((++sp & 255u) == 0u) { if (xb_ld(&bar[XB_TMO])) break; if (sp > XB_SPIN_CAP) { atomicAdd(&bar[XB_TMO], 1u); break; } }
  }
  nloc = mine > 0u ? mine : 1u; nx = cnt > 0u ? cnt : 1u;
}
__device__ __forceinline__ void xcd_barrier(const XcdBarrier& b) {
  asm volatile("s_waitcnt vmcnt(0)" ::: "memory");
  __syncthreads();
  if (threadIdx.x == 0) {
    unsigned* bar = b.bar;
    __builtin_amdgcn_s_waitcnt(0);
    unsigned nloc = b.st[0], nx = b.st[1];
    if (nloc == 0u) { xcd_barrier_complete(bar, b.x, nloc, nx); b.st[0] = nloc; b.st[1] = nx; }
    const unsigned old = xb_add(&bar[XB_XSUB(b.x)], 1u);
    const unsigned gen = old / nloc;
    if (old + 1u == (gen + 1u) * nloc) {
      __builtin_amdgcn_fence(__ATOMIC_RELEASE, "agent");
      asm volatile("s_waitcnt vmcnt(0)" ::: "memory");
      const unsigned og = xb_add(&bar[XB_TOP], 1u);
      const unsigned tg = og / nx;
      if (og + 1u == (tg + 1u) * nx) xb_add(&bar[XB_TOPGEN], 1u);
      else XB_SPIN(xb_ld(&bar[XB_TOPGEN]) == tg, bar);
      __builtin_amdgcn_fence(__ATOMIC_ACQUIRE, "agent");
      xb_add(&bar[XB_XGEN(b.x)], 1u);
      asm volatile("s_waitcnt vmcnt(0)" ::: "memory");
    } else {
      XB_SPIN(xb_ld(&bar[XB_XGEN(b.x)]) == gen, bar);
      __builtin_amdgcn_fence(__ATOMIC_ACQUIRE, "agent");
      asm volatile("s_waitcnt vmcnt(0)" ::: "memory");
    }
  }
  __syncthreads();
}

#ifndef GBK
#define GBK 64
#endif
#ifndef IMI
#define IMI 8
#endif
#define LDT GBK
#define ALDT 72
template <int MI>
__device__ __forceinline__ void gemm_core(const u16* __restrict__ A, int lda, const u16* __restrict__ Bt, int ldb,
                                          int K, u16* sA, u16* sB, f32x4 (&acc)[MI][4]) {
  constexpr int CPR = GBK / 8, RPP = 256 / CPR, NA = (32 * MI) / RPP, NB = 128 / RPP;
  const int tid = otid(), lane = tid & 63, wid = tid >> 6, wr = wid >> 1, wc = wid & 1;
  const int r16 = lane & 15, q = lane >> 4;
  const int lrow = tid / CPR, lck = (tid % CPR) * 8;
  u32x4 ra[NA], rb[NB];
  const u16* Ap = A + (size_t)lrow * lda + lck;
  const u16* Bp = Bt + (size_t)lrow * ldb + lck;
#pragma unroll
  for (int i = 0; i < NA; ++i) ra[i] = *(const u32x4*)(Ap + (size_t)i * RPP * lda);
#pragma unroll
  for (int i = 0; i < NB; ++i) rb[i] = *(const u32x4*)(Bp + (size_t)i * RPP * ldb);
  for (int k0 = 0; k0 < K; k0 += GBK) {
    __syncthreads();
#pragma unroll
    for (int i = 0; i < NA; ++i) *(u32x4*)(sA + (lrow + i * RPP) * LDT + (((tid % CPR) ^ (((lrow + i * RPP) >> 1) & 7)) * 8)) = ra[i];
#pragma unroll
    for (int i = 0; i < NB; ++i) *(u32x4*)(sB + (lrow + i * RPP) * LDT + (((tid % CPR) ^ (((lrow + i * RPP) >> 1) & 7)) * 8)) = rb[i];
    __syncthreads();
    if (k0 + GBK < K) {
#pragma unroll
      for (int i = 0; i < NA; ++i) ra[i] = *(const u32x4*)(Ap + (size_t)i * RPP * lda + k0 + GBK);
#pragma unroll
      for (int i = 0; i < NB; ++i) rb[i] = *(const u32x4*)(Bp + (size_t)i * RPP * ldb + k0 + GBK);
    }
    {
      const u16* sAw = sA + (wr * MI * 16 + r16) * LDT;
      const u16* sBw = sB + (wc * 64 + r16) * LDT;
      const int sw = r16 >> 1;
      constexpr int NS = (GBK / 32) * MI;
      constexpr int RD = (MI > 4) ? 2 : 3;
      bf16x8 bcur[4], bnext[4], ar[3];
#pragma unroll
      for (int ni = 0; ni < 4; ++ni) bcur[ni] = *(const bf16x8*)(sBw + ni * 16 * LDT + ((q ^ sw) * 8));
      ar[0] = *(const bf16x8*)(sAw + ((q ^ sw) * 8));
      if (RD > 2) ar[1] = *(const bf16x8*)(sAw + 16 * LDT + ((q ^ sw) * 8));
#pragma unroll
      for (int st = 0; st < NS; ++st) {
        const int ks = st / MI, mi = st % MI;
        if (st + RD - 1 < NS) {
          const int ks2 = (st + RD - 1) / MI, mi2 = (st + RD - 1) % MI;
          ar[(st + RD - 1) % RD] = *(const bf16x8*)(sAw + mi2 * 16 * LDT + (((ks2 * 4 + q) ^ sw) * 8));
        }
        if (mi == MI - 2 && ks + 1 < GBK / 32) {
#pragma unroll
          for (int ni = 0; ni < 4; ++ni) bnext[ni] = *(const bf16x8*)(sBw + ni * 16 * LDT + ((((ks + 1) * 4 + q) ^ sw) * 8));
        }
        __builtin_amdgcn_sched_barrier(0);
#pragma unroll
        for (int ni = 0; ni < 4; ++ni) acc[mi][ni] = MFMA(ar[st % RD], bcur[ni], acc[mi][ni]);
        __builtin_amdgcn_sched_barrier(0);
        if (mi == MI - 1 && ks + 1 < GBK / 32) {
#pragma unroll
          for (int ni = 0; ni < 4; ++ni) bcur[ni] = bnext[ni];
        }
      }
    }
  }
}

#define ZERO_ACC(acc)                                   \
  _Pragma("unroll") for (int _a = 0; _a < (int)(sizeof(acc) / sizeof(acc[0])); ++_a)      \
  _Pragma("unroll") for (int _b = 0; _b < 4; ++_b) acc[_a][_b] = f32x4{0.f, 0.f, 0.f, 0.f};

__device__ __forceinline__ void hmod_from_regs(const float (&v)[32], const float* __restrict__ modn, u16* __restrict__ outrow, int lane) {
  float s = 0.f;
#pragma unroll
  for (int i = 0; i < 32; ++i) s += v[i];
  const float mu = wave_sum(s) * (1.0f / 2048.0f);
  float s2 = 0.f;
#pragma unroll
  for (int i = 0; i < 32; ++i) { float d = v[i] - mu; s2 += d * d; }
  const float rstd = rsqrtf(wave_sum(s2) * (1.0f / 2048.0f) + 1e-5f);
#pragma unroll
  for (int i = 0; i < 8; ++i) {
    const int k = (i * 64 + lane) * 4;
    const float4 sh = *(const float4*)(modn + k);
    const float4 sc = *(const float4*)(modn + 2048 + k);
    float y0 = (v[i * 4 + 0] - mu) * rstd * (1.f + sc.x) + sh.x;
    float y1 = (v[i * 4 + 1] - mu) * rstd * (1.f + sc.y) + sh.y;
    float y2 = (v[i * 4 + 2] - mu) * rstd * (1.f + sc.z) + sh.z;
    float y3 = (v[i * 4 + 3] - mu) * rstd * (1.f + sc.w) + sh.w;
    u32x2 pk; pk.x = pack2(y0, y1); pk.y = pack2(y2, y3);
    *(u32x2*)(outrow + k) = pk;
  }
}

__device__ __forceinline__ int cond_of_row(int row) { return row < NCTX ? 0 : 1 + ((row - NCTX) >> 10); }

__device__ __forceinline__ int orig_col(int n) {
  if (n < 2560) return n;
  if (n < 3072) return 2560 + (n - 2560);
  if (n < 3584) return 512 + (n - 3072);
  if (n < 4096) return 3840 + (n - 3584);
  if (n < 4608) return 5120 + (n - 4096);
  if (n < 5120) return 3072 + (n - 4608);
  if (n < 5248) return 3584 + (n - 5120);
  if (n < 5376) return 3712 + (n - 5248);
  if (n < 5888) return 4352 + (n - 5376);
  if (n < 6016) return 4864 + (n - 5888);
  return 4992 + (n - 6016);
}

__device__ __forceinline__ void transpose_tile(const float* __restrict__ src, int lds_, u16* __restrict__ dst, int ldd, unsigned char* smem) {
  u16* tile = (u16*)smem;
  const int tid = otid();
  float v[32];
#pragma unroll
  for (int i = 0; i < 16; ++i) {
    const int kk = i * 4 + (tid >> 6), nn = tid & 63;
    v[i] = __builtin_nontemporal_load(&src[(size_t)kk * lds_ + nn]);
    v[16 + i] = __builtin_nontemporal_load(&src[(size_t)kk * lds_ + 64 + nn]);
  }
  __syncthreads();
#pragma unroll
  for (int i = 0; i < 16; ++i) {
    const int kk = i * 4 + (tid >> 6), nn = tid & 63;
    tile[kk * 66 + nn] = f2bf(v[i]);
    tile[64 * 66 + kk * 66 + nn] = f2bf(v[16 + i]);
  }
  __syncthreads();
#pragma unroll
  for (int i = 0; i < 16; ++i) {
    const int h = i >> 3, nn = (i & 7) * 8 + (tid >> 5), kk = (tid & 31) * 2;
    const unsigned pv = (unsigned)tile[h * 64 * 66 + kk * 66 + nn] | ((unsigned)tile[h * 64 * 66 + (kk + 1) * 66 + nn] << 16);
    *(unsigned*)(dst + (size_t)(h * 64 + nn) * ldd + kk) = pv;
  }
}

__device__ __forceinline__ void phase0(const Params& p, unsigned char* smem) {
  const int tid = otid(), lane = tid & 63, wid = tid >> 6;
  const int T_MOD = 768, T_TIN = 2560, T_TOUT = 1024, T_H2 = 640;
  const int total = T_MOD + T_TIN + T_TOUT + T_H2;
  for (int task = blockIdx.x; task < total; task += gridDim.x) {
    if (task < T_MOD) {
      const int kq = task & 3, t3 = task >> 2;
      const int l = t3 / 96, colc = (t3 % 96) * 64, col = colc + lane;
      const float* __restrict__ w = p.w_ada + (size_t)l * 2048 * 6144 + col;
      float acc[9];
#pragma unroll
      for (int n = 0; n < 9; ++n) acc[n] = 0.f;
      float* red = (float*)smem;
      float* tab = (float*)smem + 4 * 9 * 64;
      __syncthreads();
      for (int idx = tid; idx < 9 * 512; idx += 256) {
        const int n = idx >> 9, kk = idx & 511;
        const float cv = n == 0 ? p.c_ctx[kq * 512 + kk] : p.c[(n - 1) * 2048 + kq * 512 + kk];
        tab[idx] = silu_f(cv);
      }
      __syncthreads();
      const int kb = kq * 512 + wid * 128;
#pragma unroll 1
      for (int k32 = 0; k32 < 128; k32 += 32) {
        float wv[32];
#pragma unroll
        for (int e = 0; e < 32; ++e) wv[e] = __builtin_nontemporal_load(&w[(size_t)(kb + k32 + e) * 6144]);
#pragma unroll
        for (int e4 = 0; e4 < 32; e4 += 4) {
#pragma unroll
          for (int n = 0; n < 9; ++n) {
            const float4 tv = *(const float4*)(tab + n * 512 + wid * 128 + k32 + e4);
            acc[n] += tv.x * wv[e4] + tv.y * wv[e4 + 1] + tv.z * wv[e4 + 2] + tv.w * wv[e4 + 3];
          }
        }
      }
#pragma unroll
      for (int n = 0; n < 9; ++n) red[(wid * 9 + n) * 64 + lane] = acc[n];
      __syncthreads();
      for (int idx = tid; idx < 9 * 64; idx += 256) {
        const int n = idx >> 6, cc = idx & 63;
        float sres = red[(0 * 9 + n) * 64 + cc] + red[(1 * 9 + n) * 64 + cc] + red[(2 * 9 + n) * 64 + cc] + red[(3 * 9 + n) * 64 + cc];
        if (kq == 0) sres += p.b_ada[l * 6144 + colc + cc];
        atomicAdd(&p.mod[((size_t)l * 9 + n) * 6144 + colc + cc], sres);
      }
    } else if (task < T_MOD + T_TIN) {
      int t2 = task - T_MOD;
      const int l = t2 / 1280; t2 %= 1280;
      const int ntile = t2 / 32, ktile = t2 % 32;
      const int n0 = 1024 + ntile * 128, k0 = ktile * 64;
      const int oc = orig_col(n0);
      transpose_tile(p.w_in + ((size_t)l * 2048 + k0) * 5632 + oc, 5632, p.WinT + ((size_t)l * NIN + n0) * 2048 + k0, 2048, smem);
    } else if (task < T_MOD + T_TIN + T_TOUT) {
      int t2 = task - T_MOD - T_TIN;
      const int l = t2 / 512; t2 %= 512;
      const int ntile = t2 / 32, ktile = t2 % 32;
      transpose_tile(p.w_out + ((size_t)l * 2048 + ktile * 64) * 2048 + ntile * 128, 2048,
                     p.WoutT + ((size_t)l * 2048 + ntile * 128) * 2048 + ktile * 64, 2048, smem);
    } else {
      const int wt = (task - T_MOD - T_TIN - T_TOUT) * 4 + wid;
      const int l = wt / 1280, rem = wt % 1280;
      const int lenidx = rem < 256 ? 0 : 1;
      const int t = lenidx ? rem - 256 : rem;
      const float Lf = lenidx ? 1024.f : 256.f;
      const float tn = (float)t / Lf;
      const float* w1 = p.fw1 + l * 33 * 64;
      float h1 = p.fb1[l * 64 + lane] + tn * w1[lane];
      for (int f = 1; f <= 16; ++f) {
        float ang = 2.0f * 3.14159265358979323846f * tn * (float)f;
        h1 += cosf(ang) * w1[f * 64 + lane] + sinf(ang) * w1[(16 + f) * 64 + lane];
      }
      h1 = sinf(h1);
      const float* w2 = p.fw2 + l * 64 * 64;
      float h2v = p.fb2[l * 64 + lane];
      for (int i = 0; i < 64; ++i) h2v += __shfl(h1, i) * w2[i * 64 + lane];
      h2v = sinf(h2v);
      p.h2[((size_t)l * 1280 + (lenidx ? 256 : 0)) * 64 + (size_t)lane * (lenidx ? 1024 : 256) + t] = h2v;
    }
  }
  const size_t gtid = (size_t)blockIdx.x * 256 + tid, gstride = (size_t)gridDim.x * 256;
  {
    const float* __restrict__ win = p.w_in;
    u16* __restrict__ wab = p.WAbf;
#pragma unroll 4
    for (size_t idx = gtid; idx < (size_t)2 * 2048 * 128; idx += gstride) {
      const int l = (int)(idx >> 18), k = (int)((idx >> 7) & 2047), j4 = (int)(idx & 127) * 4;
      const f32x4 v4 = __builtin_nontemporal_load((const f32x4*)(win + ((size_t)l * 2048 + k) * 5632 + j4));
      u32x2 pk; pk.x = pack2(v4.x, v4.y); pk.y = pack2(v4.z, v4.w);
      *(u32x2*)(wab + ((size_t)l * 2048 + k) * 512 + j4) = pk;
    }
  }
  float* ctab = (float*)smem;
  __syncthreads();
  if (tid < 64) ctab[tid] = cosf((float)tid * (2.0f * 3.14159265358979323846f / 64.0f));
  __syncthreads();
  {
    const float* __restrict__ wfp = p.w_f;
    u16* __restrict__ m2t = p.M2T;
    for (size_t idx = gtid; idx < (size_t)2 * 512 * 512; idx += gstride) {
      const int l = (int)(idx >> 18), rem = (int)(idx & 262143);
      const int j = rem & 511, c = rem >> 9, g64 = j >> 6, jj = j & 63;
      const float* wf = wfp + ((size_t)l * 512 + g64 * 64) * 512 + c;
      float sc = 0.f, ss = 0.f;
#pragma unroll 16
      for (int i = 0; i < 64; ++i) {
        const int m = (jj * i) & 63;
        const float wv = wf[(size_t)i * 512];
        sc += ctab[m] * wv;
        ss += ctab[(m + 48) & 63] * wv;
      }
      m2t[((size_t)l * 1024 + c) * 512 + j] = f2bf(sc);
      m2t[((size_t)l * 1024 + 512 + c) * 512 + j] = f2bf(ss);
    }
  }
  for (size_t idx = gtid; idx < (size_t)1024 * 2048; idx += gstride) {
    int t = (int)(idx >> 11), sp = (int)(idx & 2047), s = sp & 1023;
    int m = (t * s) & 1023;
    float ang = (float)m * (2.0f * 3.14159265358979323846f / 1024.0f);
    float v = (sp < 1024 ? cosf(ang) : -sinf(ang)) * (1.0f / 256.0f);
    p.DFT1024[idx] = f2bf(v);
  }
  for (size_t idx = gtid; idx < (size_t)256 * 512; idx += gstride) {
    int t = (int)(idx >> 9), sp = (int)(idx & 511), s = sp & 255;
    int m = (t * s) & 255;
    float ang = (float)m * (2.0f * 3.14159265358979323846f / 256.0f);
    float v = (sp < 256 ? cosf(ang) : -sinf(ang)) * (1.0f / 128.0f);
    p.DFT256[idx] = f2bf(v);
  }
  for (size_t idx = gtid; idx < (size_t)1024 * 64; idx += gstride) {
    int t = (int)(idx >> 6), e = (int)(idx & 63), i = e >> 2, which = e & 3;
    float inv = powf(10000.0f, -(float)(2 * i) / 32.0f);
    float pos = (which < 2) ? (float)(t >> 6) : (float)(t & 63);
    float ang = pos * inv;
    p.rope[idx] = (which & 1) ? sinf(ang) : cosf(ang);
  }
  for (size_t idx = gtid; idx < (size_t)1048576; idx += gstride) {
    int d = (int)(idx & 63), kh = (int)((idx >> 6) & 1), pos = (int)((idx >> 7) & 255), b = (int)((idx >> 15) & 7);
    int br = (int)((idx >> 18) & 1), l = (int)(idx >> 19);
    size_t src = ((((size_t)b * 2 + l) * 256 + pos) * 2 + kh) * 64 + d;
    float kv = __builtin_nontemporal_load(&(br ? p.cdk : p.cck)[src]);
    float vv = __builtin_nontemporal_load(&(br ? p.cdv : p.ccv)[src]);
    size_t o = ((((size_t)l * 2 + br) * 8 + b) * 2 + kh);
    p.KL[(o * 1280 + 1024 + pos) * 64 + d] = f2bf(kv);
    p.VtL[(o * 64 + d) * 1280 + 1024 + pos] = f2bf(vv);
  }
}

__device__ __forceinline__ void filter_task(const Params& p, int ft, unsigned char* smem) {
  const int tid = otid(), lane = tid & 63, wid = tid >> 6;
  const int l = ft >> 9, rem = ft & 511, lenidx = rem >> 8, c2 = (rem & 255) * 4;
  const int L = lenidx ? 1024 : 256;
  const float* h2b = p.h2 + ((size_t)l * 1280 + (lenidx ? 256 : 0)) * 64;
  float* sw3 = (float*)smem;
  float* red = (float*)smem + 256;
  __syncthreads();
  { int j = tid >> 2, ch = tid & 3; sw3[tid] = p.fw3[((size_t)l * 64 + j) * 1024 + c2 + ch]; }
  __syncthreads();
  float decay[4];
#pragma unroll
  for (int ch = 0; ch < 4; ++ch) decay[ch] = expf(p.log_decay[l * 1024 + c2 + ch]);
  float hv[4][4];
  float ss[4] = {0.f, 0.f, 0.f, 0.f};
#pragma unroll
  for (int it = 0; it < 4; ++it) {
    const int t = tid + it * 256;
#pragma unroll
    for (int ch = 0; ch < 4; ++ch) hv[it][ch] = 0.f;
    if (t < L) {
      float d0 = 0.f, d1 = 0.f, d2 = 0.f, d3 = 0.f;
#pragma unroll
      for (int jq = 0; jq < 16; ++jq) {
        float4 hh;
        hh.x = h2b[(size_t)(jq * 4 + 0) * L + t]; hh.y = h2b[(size_t)(jq * 4 + 1) * L + t];
        hh.z = h2b[(size_t)(jq * 4 + 2) * L + t]; hh.w = h2b[(size_t)(jq * 4 + 3) * L + t];
        const float* wp = sw3 + jq * 16;
        d0 += hh.x * wp[0] + hh.y * wp[4] + hh.z * wp[8] + hh.w * wp[12];
        d1 += hh.x * wp[1] + hh.y * wp[5] + hh.z * wp[9] + hh.w * wp[13];
        d2 += hh.x * wp[2] + hh.y * wp[6] + hh.z * wp[10] + hh.w * wp[14];
        d3 += hh.x * wp[3] + hh.y * wp[7] + hh.z * wp[11] + hh.w * wp[15];
      }
      const float dist = fabsf((float)t - (float)(L / 2)) / (float)(L / 2);
      hv[it][0] = d0 * (expf(-dist * decay[0]) + 0.05f);
      hv[it][1] = d1 * (expf(-dist * decay[1]) + 0.05f);
      hv[it][2] = d2 * (expf(-dist * decay[2]) + 0.05f);
      hv[it][3] = d3 * (expf(-dist * decay[3]) + 0.05f);
#pragma unroll
      for (int ch = 0; ch < 4; ++ch) ss[ch] += hv[it][ch] * hv[it][ch];
    }
  }
#pragma unroll
  for (int ch = 0; ch < 4; ++ch) ss[ch] = wave_sum(ss[ch]);
  if (lane == 0) {
#pragma unroll
    for (int ch = 0; ch < 4; ++ch) red[wid * 4 + ch] = ss[ch];
  }
  __syncthreads();
  float rs[4];
#pragma unroll
  for (int ch = 0; ch < 4; ++ch) rs[ch] = rsqrtf(red[ch] + red[4 + ch] + red[8 + ch] + red[12 + ch] + 1e-6f);
  u16* FRb = p.FR + (size_t)l * 2621440 + (lenidx ? 1024 * 512 : 0) + (size_t)c2 * 2 * L;
#pragma unroll
  for (int it = 0; it < 4; ++it) {
    const int t = tid + it * 256;
    if (t < L) {
      const int ip = 3 * L / 2 - 1 - t;
#pragma unroll
      for (int ch = 0; ch < 4; ++ch) FRb[(size_t)ch * 2 * L + ip] = f2bf(hv[it][ch] * rs[ch]);
    }
  }
  for (int i = tid; i < L; i += 256) {
    const int ip = i < L / 2 ? i : i + L;
#pragma unroll
    for (int ch = 0; ch < 4; ++ch) FRb[(size_t)ch * 2 * L + ip] = 0;
  }
}

__device__ __forceinline__ void hmod_rows_task(const Params& p, int layer, int row, int lane) {
  const float* xr = row < NCTX ? p.x_prompt + (size_t)row * DM : p.x_sample + (size_t)(row - NCTX) * DM;
  float v[32];
#pragma unroll
  for (int i = 0; i < 8; ++i) {
    const f32x4 t4 = __builtin_nontemporal_load((const f32x4*)(xr + (i * 64 + lane) * 4));
    v[i * 4 + 0] = t4.x; v[i * 4 + 1] = t4.y; v[i * 4 + 2] = t4.z; v[i * 4 + 3] = t4.w;
  }
  hmod_from_regs(v, p.mod + ((size_t)layer * 9 + cond_of_row(row)) * 6144, p.hmod + (size_t)row * DM, lane);
}

__device__ __forceinline__ void phase1(const Params& p, unsigned char* smem) {
  const int tid = otid(), lane = tid & 63, wid = tid >> 6, wr = wid >> 1, wc = wid & 1, r16 = lane & 15, q = lane >> 4;
  const int total = 256 + 1024 + 3072;
  for (int task = blockIdx.x; task < total; task += gridDim.x) {
    if (task < 256) {
      const int l = task >> 7, rem = task & 127, mt = rem >> 4, nt = rem & 15;
      f32x4 acc[4][4];
      ZERO_ACC(acc);
      gemm_core<4>(p.M2T + ((size_t)l * 1024 + mt * 128) * 512, 512, p.WAbf + ((size_t)l * 2048 + nt * 128) * 512, 512, 512,
                (u16*)smem, (u16*)smem + 128 * LDT, acc);
      u16* dst = p.WinT + (size_t)l * NIN * 2048;
#pragma unroll
      for (int mi = 0; mi < 4; ++mi)
#pragma unroll
        for (int ni = 0; ni < 4; ++ni)
#pragma unroll
          for (int j = 0; j < 4; ++j) {
            int row = mt * 128 + wr * 64 + mi * 16 + q * 4 + j, col = nt * 128 + wc * 64 + ni * 16 + r16;
            dst[(size_t)row * 2048 + col] = f2bf(acc[mi][ni][j]);
          }
    } else if (task < 1280) {
      filter_task(p, task - 256, smem);
    } else {
      hmod_rows_task(p, 0, (task - 1280) * 4 + wid, lane);
    }
  }
}


template <int MIA>
__device__ __forceinline__ void wave_store_rows(const f32x4 (&a)[MIA][4], float scale, u16* wl, u16* dst, size_t ld, int lane) {
  u16* wb = wl + ((lane >> 4) * 4) * 72 + (lane & 15);
#pragma unroll
  for (int mi = 0; mi < 4; ++mi)
#pragma unroll
    for (int ni = 0; ni < 4; ++ni)
    {
      const unsigned p01 = pack2(a[mi][ni][0] * scale, a[mi][ni][1] * scale);
      const unsigned p23 = pack2(a[mi][ni][2] * scale, a[mi][ni][3] * scale);
      wb[(mi * 16 + 0) * 72 + ni * 16] = (u16)p01;
      wb[(mi * 16 + 1) * 72 + ni * 16] = (u16)(p01 >> 16);
      wb[(mi * 16 + 2) * 72 + ni * 16] = (u16)p23;
      wb[(mi * 16 + 3) * 72 + ni * 16] = (u16)(p23 >> 16);
    }
  __builtin_amdgcn_sched_barrier(0);
  const u16* rp = wl + (lane >> 3) * 72 + (lane & 7) * 8;
  u16* gp = dst + (size_t)(lane >> 3) * ld + (lane & 7) * 8;
#pragma unroll
  for (int it = 0; it < 8; it += 2) {
    const u32x4 v0 = *(const u32x4*)(rp + it * 8 * 72);
    const u32x4 v1 = *(const u32x4*)(rp + (it + 1) * 8 * 72);
    *(u32x4*)(gp + (size_t)(it * 8) * ld) = v0;
    *(u32x4*)(gp + (size_t)((it + 1) * 8) * ld) = v1;
    __builtin_amdgcn_sched_barrier(0);
  }
}

__device__ __forceinline__ void wave_store_rows_gated(const f32x4 (&a)[4][4], u16* wl, u16* dst, const u16* gsrc, size_t ld, int lane) {
  u16* wb = wl + ((lane >> 4) * 4) * 72 + (lane & 15);
#pragma unroll
  for (int mi = 0; mi < 4; ++mi)
#pragma unroll
    for (int ni = 0; ni < 4; ++ni) {
      const unsigned p01 = pack2(a[mi][ni][0], a[mi][ni][1]);
      const unsigned p23 = pack2(a[mi][ni][2], a[mi][ni][3]);
      wb[(mi * 16 + 0) * 72 + ni * 16] = (u16)p01;
      wb[(mi * 16 + 1) * 72 + ni * 16] = (u16)(p01 >> 16);
      wb[(mi * 16 + 2) * 72 + ni * 16] = (u16)p23;
      wb[(mi * 16 + 3) * 72 + ni * 16] = (u16)(p23 >> 16);
    }
  __builtin_amdgcn_sched_barrier(0);
  const u16* rp = wl + (lane >> 3) * 72 + (lane & 7) * 8;
  const size_t goff = (size_t)(lane >> 3) * ld + (lane & 7) * 8;
#pragma unroll
  for (int it = 0; it < 8; ++it) {
    const u32x4 v = *(const u32x4*)(rp + it * 8 * 72);
    const u32x4 gq = __builtin_nontemporal_load((const u32x4*)(gsrc + goff + (size_t)(it * 8) * ld));
    u32x4 o;
    o.x = pack2(__uint_as_float(v.x << 16) * silu_f(__uint_as_float(gq.x << 16)), __uint_as_float(v.x & 0xffff0000u) * silu_f(__uint_as_float(gq.x & 0xffff0000u)));
    o.y = pack2(__uint_as_float(v.y << 16) * silu_f(__uint_as_float(gq.y << 16)), __uint_as_float(v.y & 0xffff0000u) * silu_f(__uint_as_float(gq.y & 0xffff0000u)));
    o.z = pack2(__uint_as_float(v.z << 16) * silu_f(__uint_as_float(gq.z << 16)), __uint_as_float(v.z & 0xffff0000u) * silu_f(__uint_as_float(gq.z & 0xffff0000u)));
    o.w = pack2(__uint_as_float(v.w << 16) * silu_f(__uint_as_float(gq.w << 16)), __uint_as_float(v.w & 0xffff0000u) * silu_f(__uint_as_float(gq.w & 0xffff0000u)));
    *(u32x4*)(dst + goff + (size_t)(it * 8) * ld) = o;
  }
}
template <int MI>
__device__ __forceinline__ void inproj_tile(const Params& p, int layer, int mt, int nt, unsigned char* smem) {
  f32x4 acc[MI][4];
  ZERO_ACC(acc);
  gemm_core<MI>(p.hmod + (size_t)(mt * (MI * 32)) * DM, DM, p.WinT + ((size_t)layer * NIN + nt * 128) * 2048, 2048, 2048,
            (u16*)smem, (u16*)smem + (MI * 32) * LDT, acc);
  const int tid = otid(), lane = tid & 63, wid = tid >> 6, wr = wid >> 1, wc = wid & 1, r16 = lane & 15, g = lane >> 4;
  const int row0 = mt * (MI * 32), col0 = nt * 128;
  const bool isctx = row0 < NCTX;
  const int b = isctx ? (row0 >> 8) : ((row0 - NCTX) >> 10);
  const int L = isctx ? 256 : 1024;
  const int twb = (isctx ? (row0 & 255) : ((row0 - NCTX) & 1023)) + wr * (MI * 16);
  const int wcol = col0 + wc * 64;
#pragma unroll 1
  for (int mh = 0; mh < MI / 4; ++mh) {
  const int tw0 = twb + mh * 64;
  if (col0 < 3072) {
#pragma unroll
    for (int ni = 0; ni < 4; ++ni) {
      const int cp = wcol + ni * 16 + r16;
      u16* base;
      if (col0 < 1024) {
        const int half = cp >> 9, c = cp & 511;
        base = p.UT + (isctx ? (size_t)0 : (size_t)16 * 1024 * 256) + (((size_t)(b * 512 + c)) * 2 + half) * L;
      } else {
        const int cc = cp - 1024;
        base = p.BT + (isctx ? (size_t)0 : (size_t)16 * 2048 * 256) + ((size_t)(b * 2048 + cc)) * L;
      }
#pragma unroll
      for (int mi = 0; mi < 4; ++mi) {
        const int t = tw0 + mi * 16 + g * 4;
        u32x2 pk; pk.x = pack2(acc[mi][ni][0], acc[mi][ni][1]); pk.y = pack2(acc[mi][ni][2], acc[mi][ni][3]);
        *(u32x2*)(base + t) = pk;
      }
    }
  }
  if (MI > 4) {
#pragma unroll
    for (int mi = 0; mi < 4; ++mi)
#pragma unroll
      for (int ni = 0; ni < 4; ++ni) acc[mi][ni] = acc[(MI > 4 ? 4 : 0) + mi][ni];
  }
  }
}


template <int MI>
__device__ __forceinline__ void inproj_attn_tile(const Params& p, int layer, int mt, int nt, unsigned char* smem) {
  f32x4 acc[MI][4];
  ZERO_ACC(acc);
  gemm_core<MI>(p.hmod + (size_t)(mt * (MI * 32)) * DM, DM, p.WinT + ((size_t)layer * NIN + nt * 128) * 2048, 2048, 2048,
            (u16*)smem, (u16*)smem + (MI * 32) * LDT, acc);
  const int tid = otid(), lane = tid & 63, wid = tid >> 6, wr = wid >> 1, wc = wid & 1, r16 = lane & 15, g = lane >> 4;
  const int row0 = mt * (MI * 32), col0 = nt * 128;
  __syncthreads();
  u16* wl = (u16*)smem + wid * (64 * 72);
  const bool isctx = row0 < NCTX;
  const int b = isctx ? (row0 >> 8) : ((row0 - NCTX) >> 10);
  const int L = isctx ? 256 : 1024;
  const int twb = (isctx ? (row0 & 255) : ((row0 - NCTX) & 1023)) + wr * (MI * 16);
  const int wcol = col0 + wc * 64;
#pragma unroll 1
  for (int mh = 0; mh < MI / 4; ++mh) {
  const int tw0 = twb + mh * 64;
  {
    const int a = wcol - 4608;
    const int br = a >= 768 ? 1 : 0;
    const int a2 = a - br * 768;
    const int kind = a2 < 512 ? 0 : (a2 < 640 ? 1 : 2);
    const int hh = kind == 0 ? (a2 >> 6) : (kind == 1 ? ((a2 - 512) >> 6) : ((a2 - 640) >> 6));
    if (kind < 2) {
      if (br == 1) {
        const float* gn = (kind == 0 ? p.q_norm : p.k_norm) + layer * 64;
        float gw[4];
#pragma unroll
        for (int ni = 0; ni < 4; ++ni) gw[ni] = gn[ni * 16 + r16];
#pragma unroll
        for (int mi = 0; mi < 4; ++mi)
#pragma unroll
          for (int j = 0; j < 4; ++j) {
            float ss = 0.f;
#pragma unroll
            for (int ni = 0; ni < 4; ++ni) ss += acc[mi][ni][j] * acc[mi][ni][j];
            ss += __shfl_xor(ss, 1); ss += __shfl_xor(ss, 2); ss += __shfl_xor(ss, 4); ss += __shfl_xor(ss, 8);
            const float rstd = rsqrtf(ss * (1.0f / 64.0f) + 1e-6f);
#pragma unroll
            for (int ni = 0; ni < 4; ++ni) acc[mi][ni][j] *= rstd * gw[ni];
          }
      }
      if (kind == 1 && isctx) {
        float* ob = p.out + OUT_KV + (size_t)br * 2 * KVSZ;
#pragma unroll
        for (int mi = 0; mi < 4; ++mi)
#pragma unroll
          for (int j = 0; j < 4; ++j) {
            const int t = tw0 + mi * 16 + g * 4 + j;
#pragma unroll
            for (int ni = 0; ni < 4; ++ni)
              __builtin_nontemporal_store(acc[mi][ni][j], &ob[((((size_t)b * 2 + layer) * 256 + t) * 2 + hh) * 64 + ni * 16 + r16]);
          }
      }
      if (!isctx) {
#pragma unroll
        for (int mi = 0; mi < 4; ++mi) {
          __builtin_amdgcn_sched_barrier(0);
#pragma unroll
          for (int j = 0; j < 4; ++j) {
            const int t = tw0 + mi * 16 + g * 4 + j;
            const float4 rc4 = *(const float4*)(p.rope + (size_t)t * 64 + r16 * 4);
            const float cr = rc4.x, sr = rc4.y, cc = rc4.z, sc = rc4.w;
            const float x1 = acc[mi][0][j], x2 = acc[mi][1][j];
            acc[mi][0][j] = x1 * cr - x2 * sr; acc[mi][1][j] = x2 * cr + x1 * sr;
            const float y1 = acc[mi][2][j], y2 = acc[mi][3][j];
            acc[mi][2][j] = y1 * cc - y2 * sc; acc[mi][3][j] = y2 * cc + y1 * sc;
          }
        }
      }
      if (kind == 0) {
        u16* qb = p.QB + (size_t)br * NTOK * 512;
        wave_store_rows<MI>(acc, 0.125f * 1.4426950408889634f, wl, qb + (size_t)(row0 + wr * (MI * 16) + mh * 64) * 512 + hh * 64, 512, lane);
      } else {
        u16* kb;
        if (isctx) kb = p.KC + ((((size_t)br * 16 + b) * 2 + hh) * 256) * 64;
        else kb = p.KL + (((((size_t)layer * 2 + br) * 8 + b) * 2 + hh) * 1280) * 64;
        wave_store_rows<MI>(acc, 1.0f, wl, kb + (size_t)tw0 * 64, 64, lane);
      }
    } else {
      if (isctx) {
        float* ob = p.out + OUT_KV + KVSZ + (size_t)br * 2 * KVSZ;
#pragma unroll
        for (int mi = 0; mi < 4; ++mi)
#pragma unroll
          for (int j = 0; j < 4; ++j) {
            const int t = tw0 + mi * 16 + g * 4 + j;
#pragma unroll
            for (int ni = 0; ni < 4; ++ni)
              __builtin_nontemporal_store(acc[mi][ni][j], &ob[((((size_t)b * 2 + layer) * 256 + t) * 2 + hh) * 64 + ni * 16 + r16]);
          }
      }
      u16* vb; int ldv;
      if (isctx) { vb = p.VtC + ((((size_t)br * 16 + b) * 2 + hh) * 64) * 256; ldv = 256; }
      else { vb = p.VtL + (((((size_t)layer * 2 + br) * 8 + b) * 2 + hh) * 64) * 1280; ldv = 1280; }
#pragma unroll
      for (int ni = 0; ni < 4; ++ni) {
        const int d = ni * 16 + r16;
#pragma unroll
        for (int mi = 0; mi < 4; ++mi) {
          const int t = tw0 + mi * 16 + g * 4;
          u32x2 pk; pk.x = pack2(acc[mi][ni][0], acc[mi][ni][1]); pk.y = pack2(acc[mi][ni][2], acc[mi][ni][3]);
          *(u32x2*)(vb + (size_t)d * ldv + t) = pk;
        }
      }
    }
  }
  if (MI > 4) {
#pragma unroll
    for (int mi = 0; mi < 4; ++mi)
#pragma unroll
      for (int ni = 0; ni < 4; ++ni) acc[mi][ni] = acc[(MI > 4 ? 4 : 0) + mi][ni];
  }
  }
}


template <int MI>
__device__ __forceinline__ void inproj_gates_tile(const Params& p, int layer, int mt, int nt, unsigned char* smem) {
  f32x4 acc[MI][4];
  ZERO_ACC(acc);
  gemm_core<MI>(p.hmod + (size_t)(mt * (MI * 32)) * DM, DM, p.WinT + ((size_t)layer * NIN + nt * 128) * 2048, 2048, 2048,
                (u16*)smem, (u16*)smem + (MI * 32) * LDT, acc);
  const int tid = otid(), lane = tid & 63, wid = tid >> 6, wr = wid >> 1, wc = wid & 1;
  const int row0 = mt * (MI * 32), col0 = nt * 128, wcol = col0 + wc * 64;
  __syncthreads();
  u16* wl = (u16*)smem + wid * (64 * 72);
  u16* dstb = p.G + (size_t)(row0 + wr * (MI * 16)) * 2048 + (col0 < 3584 ? wcol - 3072 : wcol - 2560);
#pragma unroll 1
  for (int mh = 0; mh < MI / 4; ++mh) {
    wave_store_rows<MI>(acc, 1.0f, wl, dstb + (size_t)mh * 64 * 2048, 2048, lane);
    if (MI > 4) {
#pragma unroll
      for (int mi = 0; mi < 4; ++mi)
#pragma unroll
        for (int ni = 0; ni < 4; ++ni) acc[mi][ni] = acc[(MI > 4 ? 4 : 0) + mi][ni];
    }
  }
}

__device__ __forceinline__ void fourier_tile(const Params& p, int path, int mt, int nt, unsigned char* smem) {
  const int tid = otid(), lane = tid & 63, wid = tid >> 6, wr = wid >> 1, wc = wid & 1, r16 = lane & 15, g = lane >> 4;
  const int L = path ? 1024 : 256;
  const u16* A = (path ? p.DFT1024 : p.DFT256) + (size_t)mt * 128 * 2 * L;
  const u16* Bt = p.UT + (path ? (size_t)16 * 1024 * 256 : (size_t)0) + (size_t)nt * 128 * 2 * L;
  f32x4 acc[4][4];
  ZERO_ACC(acc);
  gemm_core<4>(A, 2 * L, Bt, 2 * L, 2 * L, (u16*)smem, (u16*)smem + 128 * LDT, acc);
  const int b = nt >> 2, c0 = (nt & 3) * 128;
  const int rowbase = (path ? NCTX + b * 1024 : b * 256) + mt * 128 + wr * 64;
  __syncthreads();
  wave_store_rows_gated(acc, (u16*)smem + wid * (64 * 72), p.hmod + (size_t)rowbase * 2048 + c0 + wc * 64,
                        p.G + (size_t)rowbase * 2048 + c0 + wc * 64, 2048, lane);
}

__device__ __forceinline__ float conv3_at(const u16* __restrict__ rowp, int t, int L, float w0, float w1, float w2, float bias) {
  float u0 = t > 0 ? bf2f(rowp[t - 1]) : 0.f;
  float u1 = bf2f(rowp[t]);
  float u2 = t < L - 1 ? bf2f(rowp[t + 1]) : 0.f;
  return u0 * w0 + u1 * w1 + u2 * w2 + bias;
}


__device__ __forceinline__ void conv3_x4(const u16* __restrict__ rowp, int t, int L, float w0, float w1, float w2, float bias, float (&out)[4]) {
  const u32x2 r4 = *(const u32x2*)(rowp + t);
  float u[6];
  u[0] = t > 0 ? bf2f(rowp[t - 1]) : 0.f;
  u[5] = t + 4 < L ? bf2f(rowp[t + 4]) : 0.f;
  u[1] = __uint_as_float(r4.x << 16); u[2] = __uint_as_float(r4.x & 0xffff0000u);
  u[3] = __uint_as_float(r4.y << 16); u[4] = __uint_as_float(r4.y & 0xffff0000u);
#pragma unroll
  for (int j = 0; j < 4; ++j) out[j] = u[j] * w0 + u[j + 1] * w1 + u[j + 2] * w2 + bias;
}

template <int L>
__device__ __forceinline__ void filter_vec_load(const u16* __restrict__ Gf, int tid, u32x4& a, u32x4& b) {
  constexpr int NV = 2 * L / 8;
  a = u32x4{0u, 0u, 0u, 0u}; b = u32x4{0u, 0u, 0u, 0u};
  if (tid < NV) {
    a = __builtin_nontemporal_load((const u32x4*)(Gf + tid * 8));
    if (tid + 1 < NV) b = __builtin_nontemporal_load((const u32x4*)(Gf + tid * 8 + 8));
  }
}
template <int L>
__device__ __forceinline__ void filter_copies_store(const u32x4& a, const u32x4& b, unsigned char* smem, int tid) {
  constexpr int FS = 2 * L * 2 + 32;
  constexpr int NV = 2 * L / 8;
  if (tid < NV) {
    const unsigned w[8] = {a.x, a.y, a.z, a.w, b.x, b.y, b.z, b.w};
#pragma unroll
    for (int m = 0; m < 8; ++m) {
      u32x4 o;
      if (m & 1) {
        o.x = (w[0 + m / 2] >> 16) | (w[1 + m / 2] << 16);
        o.y = (w[1 + m / 2] >> 16) | (w[2 + m / 2] << 16);
        o.z = (w[2 + m / 2] >> 16) | (w[3 + m / 2] << 16);
        o.w = (w[3 + m / 2] >> 16) | (w[4 + m / 2] << 16);
      } else {
        o.x = w[0 + m / 2]; o.y = w[1 + m / 2]; o.z = w[2 + m / 2]; o.w = w[3 + m / 2];
      }
      *(u32x4*)(smem + m * FS + tid * 16) = o;
    }
  }
}
template <int NT>
__device__ __forceinline__ void row_prefetch(const u16* __restrict__ rowp, int tb, int tlo, int thi, int L, u32x2 (&r)[NT], float& elo, float& ehi) {
#pragma unroll
  for (int i = 0; i < NT; ++i) r[i] = *(const u32x2*)(rowp + tb + i * 16);
  elo = tlo >= 0 ? bf2f(rowp[tlo >= 0 ? tlo : 0]) : 0.f;
  ehi = thi < L ? bf2f(rowp[thi < L ? thi : 0]) : 0.f;
}
template <int NT>
__device__ __forceinline__ void conv3_pref(const u32x2 (&r)[NT], int i, int lane, int g, float elo, float ehi, float w0, float w1, float w2,
                                           float bias, float (&out)[4]) {
  const unsigned upv = (unsigned)__shfl((int)r[i].y, lane - 16);
  const unsigned up0 = (unsigned)__shfl((int)r[i > 0 ? i - 1 : 0].y, lane + 48);
  const unsigned dnv = (unsigned)__shfl((int)r[i].x, lane + 16);
  const unsigned dn3 = (unsigned)__shfl((int)r[i + 1 < NT ? i + 1 : NT - 1].x, lane - 48);
  float u[6];
  u[0] = g > 0 ? __uint_as_float(upv & 0xffff0000u) : (i > 0 ? __uint_as_float(up0 & 0xffff0000u) : elo);
  u[5] = g < 3 ? __uint_as_float(dnv << 16) : (i + 1 < NT ? __uint_as_float(dn3 << 16) : ehi);
  u[1] = __uint_as_float(r[i].x << 16); u[2] = __uint_as_float(r[i].x & 0xffff0000u);
  u[3] = __uint_as_float(r[i].y << 16); u[4] = __uint_as_float(r[i].y & 0xffff0000u);
#pragma unroll
  for (int j = 0; j < 4; ++j) out[j] = u[j] * w0 + u[j + 1] * w1 + u[j + 2] * w2 + bias;
}

template <int L, int NB>
__device__ __forceinline__ void hyena_item(const Params& p, int layer, int c, unsigned char* smem) {
  constexpr int NT = L / 64;
  constexpr int FS = 2 * L * 2 + 32;
  constexpr int VS = L * 2 + 16;
  constexpr int VOFF = 8 * (4096 + 32);
  constexpr int path = (L == 1024) ? 1 : 0;
  const int tid = otid(), lane = tid & 63, w = tid >> 6, r16 = lane & 15, g = lane >> 4;
  const u16* raw = p.BT + (path ? (size_t)16 * 2048 * 256 : (size_t)0);
  const float* cw = p.conv_w + (size_t)layer * 3 * 1536;
  const float* cb = p.conv_b + (size_t)layer * 1536;
  const u16* FRb = p.FR + (size_t)layer * 2621440 + (path ? 1024 * 512 : 0);
  unsigned char* vbuf = smem + VOFF;
  const int wv = __builtin_amdgcn_readfirstlane(w);
  const int bl = r16 & (NB - 1);
  const int tb = wv * NT * 16 + g * 4;
  const int tlo = wv * NT * 16 - 1, thi = (wv + 1) * NT * 16;

  u32x4 fa1, fb1, fa2, fb2;
  filter_vec_load<L>(FRb + (size_t)c * 2 * L, tid, fa1, fb1);
  filter_vec_load<L>(FRb + (size_t)(512 + c) * 2 * L, tid, fa2, fb2);
  u32x2 r1[NT];
  float e1lo, e1hi;
  row_prefetch<NT>(raw + ((size_t)(bl * 2048 + 512 + c)) * L, tb, tlo, thi, L, r1, e1lo, e1hi);
  {
    const float w0 = cw[c], w1 = cw[1536 + c], w2 = cw[3072 + c], bias = cb[c];
#pragma unroll
    for (int it = 0; it < NB * L / 8 / 256; ++it) {
      const int vi = tid + it * 256;
      const int b = vi / (L / 8), s8 = (vi % (L / 8)) * 8;
      const u16* rowp = raw + ((size_t)(b * 2048 + c)) * L;
      const u32x4 rv = *(const u32x4*)(rowp + s8);
      float u[10];
      u[0] = s8 > 0 ? bf2f(rowp[s8 > 0 ? s8 - 1 : 0]) : 0.f;
      u[9] = s8 + 8 < L ? bf2f(rowp[s8 + 8 < L ? s8 + 8 : 0]) : 0.f;
      u[1] = __uint_as_float(rv.x << 16); u[2] = __uint_as_float(rv.x & 0xffff0000u);
      u[3] = __uint_as_float(rv.y << 16); u[4] = __uint_as_float(rv.y & 0xffff0000u);
      u[5] = __uint_as_float(rv.z << 16); u[6] = __uint_as_float(rv.z & 0xffff0000u);
      u[7] = __uint_as_float(rv.w << 16); u[8] = __uint_as_float(rv.w & 0xffff0000u);
      float o[8];
#pragma unroll
      for (int e = 0; e < 8; ++e) o[e] = u[e] * w0 + u[e + 1] * w1 + u[e + 2] * w2 + bias;
      u32x4 pk; pk.x = pack2(o[0], o[1]); pk.y = pack2(o[2], o[3]); pk.z = pack2(o[4], o[5]); pk.w = pack2(o[6], o[7]);
      *(u32x4*)(vbuf + b * VS + s8 * 2) = pk;
    }
  }
  filter_copies_store<L>(fa1, fb1, smem, tid);
  __syncthreads();

  const int idxb = 8 * g - (wv * NT) * 16 - r16 + L - 1;
  const int mcp = idxb & 7;
  const unsigned char* abase = smem + mcp * FS + (idxb - mcp) * 2;
  const unsigned char* bbase = vbuf + bl * VS + g * 16;
  f32x4 acc[NT];
#pragma unroll
  for (int i = 0; i < NT; ++i) acc[i] = f32x4{0.f, 0.f, 0.f, 0.f};
  {
    bf16x8 ring[NT];
#pragma unroll
    for (int i = 0; i < NT; ++i) ring[(NT - i) % NT] = *(const bf16x8*)(abase - i * 32);
    for (int st0 = 0; st0 < L / 32; st0 += NT / 2) {
#pragma unroll
      for (int u = 0; u < NT / 2; ++u) {
        const int st = st0 + u;
        const bf16x8 bfr = *(const bf16x8*)(bbase + st * 64);
        ring[(2 * u) % NT] = *(const bf16x8*)(abase + st * 64);
        ring[(2 * u - 1 + NT) % NT] = *(const bf16x8*)(abase + st * 64 - 32);
#pragma unroll
        for (int i = NT - 1; i >= 0; --i) acc[i] = MFMA(ring[(2 * u - i + 2 * NT) % NT], bfr, acc[i]);
      }
    }
  }
  __syncthreads();
  {
    const float w0 = cw[512 + c], w1 = cw[1536 + 512 + c], w2 = cw[3072 + 512 + c], bias = cb[512 + c];
    const float sk = p.skip[layer * 1024 + c];
#pragma unroll
    for (int i = 0; i < NT; ++i) {
      float x1[4];
      conv3_pref<NT>(r1, i, lane, g, e1lo, e1hi, w0, w1, w2, bias, x1);
      if (r16 < NB) {
        u32x2* vp = (u32x2*)(vbuf + bl * VS + (tb + i * 16) * 2);
        const u32x2 vv = *vp;
        float z[4];
        z[0] = x1[0] * (acc[i][0] + sk * __uint_as_float(vv.x << 16));
        z[1] = x1[1] * (acc[i][1] + sk * __uint_as_float(vv.x & 0xffff0000u));
        z[2] = x1[2] * (acc[i][2] + sk * __uint_as_float(vv.y << 16));
        z[3] = x1[3] * (acc[i][3] + sk * __uint_as_float(vv.y & 0xffff0000u));
        u32x2 pk; pk.x = pack2(z[0], z[1]); pk.y = pack2(z[2], z[3]);
        *vp = pk;
      }
    }
  }
  u32x2 r2[NT], rg[NT];
  float e2lo, e2hi, dmy0, dmy1;
  row_prefetch<NT>(raw + ((size_t)(bl * 2048 + 1024 + c)) * L, tb, tlo, thi, L, r2, e2lo, e2hi);
  row_prefetch<NT>(raw + ((size_t)(bl * 2048 + 1536 + c)) * L, tb, -1, L, L, rg, dmy0, dmy1);
  filter_copies_store<L>(fa2, fb2, smem, tid);
  __syncthreads();
#pragma unroll
  for (int i = 0; i < NT; ++i) acc[i] = f32x4{0.f, 0.f, 0.f, 0.f};
  {
    bf16x8 ring[NT];
#pragma unroll
    for (int i = 0; i < NT; ++i) ring[(NT - i) % NT] = *(const bf16x8*)(abase - i * 32);
    for (int st0 = 0; st0 < L / 32; st0 += NT / 2) {
#pragma unroll
      for (int u = 0; u < NT / 2; ++u) {
        const int st = st0 + u;
        const bf16x8 bfr = *(const bf16x8*)(bbase + st * 64);
        ring[(2 * u) % NT] = *(const bf16x8*)(abase + st * 64);
        ring[(2 * u - 1 + NT) % NT] = *(const bf16x8*)(abase + st * 64 - 32);
#pragma unroll
        for (int i = NT - 1; i >= 0; --i) acc[i] = MFMA(ring[(2 * u - i + 2 * NT) % NT], bfr, acc[i]);
      }
    }
  }
  {
    const float w0 = cw[1024 + c], w1 = cw[1536 + 1024 + c], w2 = cw[3072 + 1024 + c], bias = cb[1024 + c];
    const float sk = p.skip[layer * 1024 + 512 + c];
    const int rowbase = path ? NCTX + bl * 1024 : bl * 256;
#pragma unroll
    for (int i = 0; i < NT; ++i) {
      float x2v[4];
      conv3_pref<NT>(r2, i, lane, g, e2lo, e2hi, w0, w1, w2, bias, x2v);
      if (r16 < NB) {
        const int t = tb + i * 16;
        const u32x2 vv = *(const u32x2*)(vbuf + bl * VS + t * 2);
        float zz[4], gt[4];
        zz[0] = __uint_as_float(vv.x << 16); zz[1] = __uint_as_float(vv.x & 0xffff0000u);
        zz[2] = __uint_as_float(vv.y << 16); zz[3] = __uint_as_float(vv.y & 0xffff0000u);
        gt[0] = __uint_as_float(rg[i].x << 16); gt[1] = __uint_as_float(rg[i].x & 0xffff0000u);
        gt[2] = __uint_as_float(rg[i].y << 16); gt[3] = __uint_as_float(rg[i].y & 0xffff0000u);
#pragma unroll
        for (int j = 0; j < 4; ++j) {
          const float val = x2v[j] * (acc[i][j] + sk * zz[j]);
          const size_t row = (size_t)(rowbase + t + j);
          p.hmod[row * 2048 + 512 + c] = f2bf(val * silu_f(gt[j]));
        }
      }
    }
  }
}

__device__ __forceinline__ void attn_item(const Params& p, int layer, int path, int br, int b, int h, int qb, unsigned char* smem) {
  const int tid = otid(), lane = tid & 63, w = tid >> 6, r16 = lane & 15, g = lane >> 4;
  const int rowbase = path ? NCTX + b * 1024 : b * 256;
  const int kh = h >> 2;
  const u16* Kb; const u16* Vb; int ldv;
  if (path) { size_t o = ((((size_t)layer * 2 + br) * 8 + b) * 2 + kh); Kb = p.KL + o * 1280 * 64; Vb = p.VtL + o * 64 * 1280; ldv = 1280; }
  else { size_t o = (((size_t)br * 16 + b) * 2 + kh); Kb = p.KC + o * 256 * 64; Vb = p.VtC + o * 64 * 256; ldv = 256; }
  constexpr int VLD = 136;
  u16* sK = (u16*)smem;
  u16* sV = (u16*)smem + 128 * 64;
  bf16x8 qf[2][2];
  const u16* Qb = p.QB + (size_t)br * NTOK * 512;
#pragma unroll
  for (int qt = 0; qt < 2; ++qt)
#pragma unroll
    for (int ks = 0; ks < 2; ++ks) {
      const int qrow = rowbase + qb * 128 + w * 32 + qt * 16 + r16;
      qf[qt][ks] = *(const bf16x8*)(Qb + (size_t)qrow * 512 + h * 64 + ks * 32 + g * 8);
    }
  float m[2], ls[2];
  f32x4 o[4][2];
#pragma unroll
  for (int dt = 0; dt < 4; ++dt)
#pragma unroll
    for (int qt = 0; qt < 2; ++qt) o[dt][qt] = f32x4{0.f, 0.f, 0.f, 0.f};
  if (br == 0) { const float sk = p.sink[layer * 8 + h] * 1.4426950408889634f;   m[0] = m[1] = sk; ls[0] = ls[1] = (g == 0) ? 1.f : 0.f; }
  else { m[0] = m[1] = -1e30f; ls[0] = ls[1] = 0.f; }
  int ntiles, wlo = 0;
  const bool windowed = (path == 1 && br == 0);
  if (!path) ntiles = 2;
  else if (br == 1) ntiles = 10;
  else { wlo = max(0, qb - 1); const int whi = min(8, qb + 2); ntiles = 2 + whi - wlo; }
  auto kstart_of = [&](int i) -> int {
    if (!windowed) return i * 128;
    return i < 2 ? 1024 + i * 128 : (wlo + i - 2) * 128;
  };
  const int lrow = tid >> 3, lck = (tid & 7) * 8;
  u32x4 rk[4], rv[4];
  const int vrow = tid >> 4, vck = (tid & 15) * 8;
  {
    const int ks0 = kstart_of(0);
#pragma unroll
    for (int j = 0; j < 4; ++j) {
      rk[j] = *(const u32x4*)(Kb + (size_t)(ks0 + lrow + j * 32) * 64 + lck);
      rv[j] = *(const u32x4*)(Vb + (size_t)(vrow + j * 16) * ldv + ks0 + vck);
    }
  }
  for (int it = 0; it < ntiles; ++it) {
    const int kst = kstart_of(it);
    __syncthreads();
#pragma unroll
    for (int j = 0; j < 4; ++j) {
      *(u32x4*)(sK + (lrow + j * 32) * 64 + (((tid & 7) ^ (((lrow + j * 32) >> 1) & 7)) * 8)) = rk[j];
      *(u32x4*)(sV + (vrow + j * 16) * VLD + vck) = rv[j];
    }
    __syncthreads();
    if (it + 1 < ntiles) {
      const int ks1 = kstart_of(it + 1);
#pragma unroll
      for (int j = 0; j < 4; ++j) {
        rk[j] = *(const u32x4*)(Kb + (size_t)(ks1 + lrow + j * 32) * 64 + lck);
        rv[j] = *(const u32x4*)(Vb + (size_t)(vrow + j * 16) * ldv + ks1 + vck);
      }
    }
    f32x4 s[8][2];
#pragma unroll
    for (int kk = 0; kk < 8; ++kk) {
      const bf16x8 kf0 = *(const bf16x8*)(sK + (kk * 16 + r16) * 64 + ((g ^ (r16 >> 1)) * 8));
      const bf16x8 kf1 = *(const bf16x8*)(sK + (kk * 16 + r16) * 64 + (((4 + g) ^ (r16 >> 1)) * 8));
#pragma unroll
      for (int qt = 0; qt < 2; ++qt) {
        f32x4 z = f32x4{0.f, 0.f, 0.f, 0.f};
        z = MFMA(kf0, qf[qt][0], z);
        s[kk][qt] = MFMA(kf1, qf[qt][1], z);
      }
    }
    const int q0w = qb * 128 + __builtin_amdgcn_readfirstlane(w) * 32;
    if (windowed && it >= 2 && (kst + 127 - q0w > 128 || q0w + 31 - kst > 128)) {
      asm volatile("" ::: "memory");
#pragma unroll
      for (int kk = 0; kk < 8; ++kk)
#pragma unroll
        for (int qt = 0; qt < 2; ++qt)
#pragma unroll
          for (int j = 0; j < 4; ++j) {
            const int kpos = kst + kk * 16 + g * 4 + j;
            const int qpos = qb * 128 + w * 32 + qt * 16 + r16;
            const int df = kpos - qpos;
            if (df > 128 || df < -128) s[kk][qt][j] = -1e30f;
          }
    }
#pragma unroll
    for (int qt = 0; qt < 2; ++qt) {
      float mx = -1e30f;
#pragma unroll
      for (int kk = 0; kk < 8; ++kk)
#pragma unroll
        for (int j = 0; j < 4; ++j) mx = fmaxf(mx, s[kk][qt][j]);
      mx = fmaxf(mx, __shfl_xor(mx, 16));
      mx = fmaxf(mx, __shfl_xor(mx, 32));
      const float mnew = fmaxf(m[qt], mx);
      const float alpha = __builtin_amdgcn_exp2f(m[qt] - mnew);
      m[qt] = mnew;
      float psum = 0.f;
#pragma unroll
      for (int kk = 0; kk < 8; ++kk)
#pragma unroll
        for (int j = 0; j < 4; ++j) {
          const float pv = __builtin_amdgcn_exp2f(s[kk][qt][j] - mnew);
          psum += pv;
          s[kk][qt][j] = pv;
        }
      ls[qt] = ls[qt] * alpha + psum;
#pragma unroll
      for (int dt = 0; dt < 4; ++dt) {
        o[dt][qt][0] *= alpha; o[dt][qt][1] *= alpha; o[dt][qt][2] *= alpha; o[dt][qt][3] *= alpha;
      }
    }
#pragma unroll
    for (int c = 0; c < 4; ++c) {
      bf16x8 pf[2];
#pragma unroll
      for (int qt = 0; qt < 2; ++qt) {
        u32x4 cvt;
        cvt.x = pack2(s[2 * c][qt][0], s[2 * c][qt][1]);
        cvt.y = pack2(s[2 * c][qt][2], s[2 * c][qt][3]);
        cvt.z = pack2(s[2 * c + 1][qt][0], s[2 * c + 1][qt][1]);
        cvt.w = pack2(s[2 * c + 1][qt][2], s[2 * c + 1][qt][3]);
        pf[qt] = __builtin_bit_cast(bf16x8, cvt);
      }
#pragma unroll
      for (int dt = 0; dt < 4; ++dt) {
        const u32x2 vlo = *(const u32x2*)(sV + (dt * 16 + r16) * VLD + c * 32 + g * 4);
        const u32x2 vhi = *(const u32x2*)(sV + (dt * 16 + r16) * VLD + c * 32 + 16 + g * 4);
        u32x4 vv4; vv4.x = vlo.x; vv4.y = vlo.y; vv4.z = vhi.x; vv4.w = vhi.y;
        const bf16x8 vfv = __builtin_bit_cast(bf16x8, vv4);
#pragma unroll
        for (int qt = 0; qt < 2; ++qt) o[dt][qt] = MFMA(vfv, pf[qt], o[dt][qt]);
      }
    }
  }
  const int gcol = 1024 + br * 512 + h * 64;
#pragma unroll
  for (int qt = 0; qt < 2; ++qt) {
    float lt = ls[qt];
    lt += __shfl_xor(lt, 16);
    lt += __shfl_xor(lt, 32);
    const float inv = 1.0f / lt;
    const size_t row = (size_t)(rowbase + qb * 128 + w * 32 + qt * 16 + r16);
#pragma unroll
    for (int dt = 0; dt < 4; ++dt) {
      const int d = dt * 16 + g * 4;
      const u32x2 gg = *(const u32x2*)(p.G + row * 2048 + gcol + d);
      const float g0 = bf2f((u16)(gg.x & 0xffff)), g1 = bf2f((u16)(gg.x >> 16)), g2 = bf2f((u16)(gg.y & 0xffff)), g3 = bf2f((u16)(gg.y >> 16));
      u32x2 pk;
      pk.x = pack2(o[dt][qt][0] * inv * silu_f(g0), o[dt][qt][1] * inv * silu_f(g1));
      pk.y = pack2(o[dt][qt][2] * inv * silu_f(g2), o[dt][qt][3] * inv * silu_f(g3));
      *(u32x2*)(p.hmod + row * 2048 + gcol + d) = pk;
    }
  }
}

__device__ __forceinline__ void mixer_phase(const Params& p, int layer, unsigned char* smem, int* s_item, int cidx, int tmask) {
  bool first_round = true;
  for (;;) {
    __syncthreads();
    if (threadIdx.x == 0) *s_item = first_round ? (int)blockIdx.x : (int)(atomicAdd(p.ctr + cidx, 1u) + gridDim.x);
    first_round = false;
    __syncthreads();
    const int item = __builtin_amdgcn_readfirstlane(*s_item);
    if (item >= MIX_ITEMS) break;
    int type, a0 = 0, a1 = 0, a2 = 0, a3 = 0, a4 = 0;
    if (item < 512) { type = 0; a0 = 1; a1 = 1; a2 = item >> 6; a3 = (item >> 3) & 7; a4 = item & 7; }
    else if (item < 768) { const int i2 = item - 512; type = 1; a0 = 1; a1 = i2 & 7; a2 = i2 >> 3; }
    else if (item < 1280) { type = 2; a0 = item - 768; }
    else if (item < 1792) { const int i4 = item - 1280; type = 0; a0 = 1; a1 = 0; a2 = i4 >> 6; a3 = (i4 >> 3) & 7; a4 = i4 & 7; }
    else if (item < 2304) { const int i5 = item - 1792; type = 0; a0 = 0; a1 = i5 >> 8; a2 = (i5 >> 4) & 15; a3 = (i5 >> 1) & 7; a4 = i5 & 1; }
    else if (item < 2432) { const int i6 = item - 2304; type = 1; a0 = 0; a1 = i6 & 1; a2 = i6 >> 1; }
    else { type = 3; a0 = item - 2432; }
    if (!((tmask >> type) & 1)) continue;
    if (type >= 2 && cidx < 2) {
      if (threadIdx.x == 0) {
        const unsigned x0 = xb_xcc_id() & 7u;
        unsigned* hc = p.ctr + 8 + (layer * 2 + (type - 2)) * 8;
        int ch = a0;
        for (unsigned tr = 0; tr < 8u; ++tr) {
          const unsigned xx = (x0 + tr) & 7u;
          const unsigned idx = atomicAdd(hc + xx, 1u);
          if (idx < 64u) { ch = (int)(xx * 64u + idx); break; }
        }
        s_item[1] = ch;
      }
      __syncthreads();
      a0 = __builtin_amdgcn_readfirstlane(s_item[1]);
    }
    if (type == 0) { if (PM & 8) attn_item(p, layer, a0, a1, a2, a3, a4, smem); }
    else if (type == 1) { if (PM & 16) fourier_tile(p, a0, a1, a2, smem); }
    else if (type == 2) { if (PM & 32) hyena_item<1024, 8>(p, layer, a0, smem); }
    else { if (PM & 64) hyena_item<256, 16>(p, layer, a0, smem); }
  }
}

template <int MI>
__device__ __forceinline__ void outproj_tile(const Params& p, int layer, int mt, int nt, unsigned char* smem) {
  const int tid = otid(), lane = tid & 63, wid = tid >> 6, wr = wid >> 1, wc = wid & 1, r16 = lane & 15, g = lane >> 4;
  const int row0 = mt * (MI * 32), col0 = nt * 128;
  f32x4 acc[MI][4];
  ZERO_ACC(acc);
  gemm_core<MI>(p.hmod + (size_t)row0 * DM, DM, p.WoutT + ((size_t)layer * 2048 + col0) * 2048, 2048, 2048,
            (u16*)smem, (u16*)smem + (MI * 32) * LDT, acc);
  const float* gatep = p.mod + ((size_t)layer * 9 + cond_of_row(row0)) * 6144 + 4096;
  u16* Y = (u16*)p.R;
  float gt[4];
#pragma unroll
  for (int ni = 0; ni < 4; ++ni) gt[ni] = gatep[col0 + wc * 64 + ni * 16 + r16];
  __syncthreads();
  u16* wl = (u16*)smem + wid * (64 * 72);
#pragma unroll 1
  for (int mh = 0; mh < MI / 4; ++mh) {
#pragma unroll
    for (int mi = 0; mi < 4; ++mi)
#pragma unroll
      for (int ni = 0; ni < 4; ++ni) {
        acc[mi][ni][0] *= gt[ni]; acc[mi][ni][1] *= gt[ni]; acc[mi][ni][2] *= gt[ni]; acc[mi][ni][3] *= gt[ni];
      }
    wave_store_rows<MI>(acc, 1.0f, wl, Y + (size_t)(row0 + wr * (MI * 16) + mh * 64) * DM + col0 + wc * 64, DM, lane);
    if (MI > 4) {
#pragma unroll
      for (int mi = 0; mi < 4; ++mi)
#pragma unroll
        for (int ni = 0; ni < 4; ++ni) acc[mi][ni] = acc[(MI > 4 ? 4 : 0) + mi][ni];
    }
  }
}

__device__ __forceinline__ void ln_phase(const Params& p, int layer) {
  const int tid = otid(), lane = tid & 63, wid = tid >> 6;
  const float* lg = p.ln_g + layer * DM;
  const float* lb = p.ln_b + layer * DM;
  for (int task = blockIdx.x; task < NTOK / 4; task += gridDim.x) {
    const int row = task * 4 + wid;
    const u16* yy = (const u16*)p.R + (size_t)row * DM;
    const float* xr = layer == 0 ? (row < NCTX ? p.x_prompt + (size_t)row * DM : p.x_sample + (size_t)(row - NCTX) * DM)
                                 : p.out + (size_t)row * DM;
    const float ALPHA = 1.41421356237309515f;
    float v[32];
#pragma unroll
    for (int i = 0; i < 8; ++i) {
      const f32x4 t4 = __builtin_nontemporal_load((const f32x4*)(xr + (i * 64 + lane) * 4));
      const u32x2 h4 = __builtin_nontemporal_load((const u32x2*)(yy + (i * 64 + lane) * 4));
      v[i * 4 + 0] = ALPHA * t4.x + __uint_as_float(h4.x << 16);
      v[i * 4 + 1] = ALPHA * t4.y + __uint_as_float(h4.x & 0xffff0000u);
      v[i * 4 + 2] = ALPHA * t4.z + __uint_as_float(h4.y << 16);
      v[i * 4 + 3] = ALPHA * t4.w + __uint_as_float(h4.y & 0xffff0000u);
    }
    float s = 0.f;
#pragma unroll
    for (int i = 0; i < 32; ++i) s += v[i];
    const float mu = wave_sum(s) * (1.0f / 2048.0f);
    float s2 = 0.f;
#pragma unroll
    for (int i = 0; i < 32; ++i) { float d = v[i] - mu; s2 += d * d; }
    const float rstd = rsqrtf(wave_sum(s2) * (1.0f / 2048.0f) + 1e-5f);
    float* orow = p.out + (size_t)row * DM;
#pragma unroll
    for (int i = 0; i < 8; ++i) {
      const int k = (i * 64 + lane) * 4;
      const float4 g4 = *(const float4*)(lg + k);
      const float4 b4 = *(const float4*)(lb + k);
      float4 y;
      y.x = (v[i * 4 + 0] - mu) * rstd * g4.x + b4.x;
      y.y = (v[i * 4 + 1] - mu) * rstd * g4.y + b4.y;
      y.z = (v[i * 4 + 2] - mu) * rstd * g4.z + b4.z;
      y.w = (v[i * 4 + 3] - mu) * rstd * g4.w + b4.w;
      __builtin_nontemporal_store(f32x4{y.x, y.y, y.z, y.w}, (f32x4*)(orow + k));
      v[i * 4 + 0] = y.x; v[i * 4 + 1] = y.y; v[i * 4 + 2] = y.z; v[i * 4 + 3] = y.w;
    }
    if (layer == 0) hmod_from_regs(v, p.mod + ((size_t)1 * 9 + cond_of_row(row)) * 6144, p.hmod + (size_t)row * DM, lane);
  }
}

__global__ void __launch_bounds__(256, 2) fwd_megakernel(Params p) {
  __shared__ __attribute__((aligned(16))) unsigned char smem[(IMI * 32 + 128) * LDT * 2 > 49536 ? (IMI * 32 + 128) * LDT * 2 : 49536];
  __shared__ int s_item[2];
  cg::grid_group grid = cg::this_grid();
  __shared__ u32x4 xb_words;
  if (threadIdx.x == 0) xb_words = u32x4{0u, 0u, 0u, 0u};
  __syncthreads();
  XcdBarrier xb = xcd_barrier_post(p.bar, (volatile LAS unsigned*)&xb_words);
  if (p.phase_hi > 1000) grid.sync();
#define PH(n) (p.phase_lo <= (n) && (n) < p.phase_hi)
#define GSYNC(n) if (p.phase_lo < (n) && (n) < p.phase_hi) { xcd_barrier(xb); if (DUP & 64) { xcd_barrier(xb); xcd_barrier(xb); } }
  if (PH(0)) { if (PM & 1) phase0(p, smem); if (DUP & 16) phase0(p, smem); }
  GSYNC(1);
  if (PH(1)) { if (PM & 2) phase1(p, smem); if (DUP & 32) phase1(p, smem); }
  for (int layer = 0; layer < 2; ++layer) {
    GSYNC(2 + 4 * layer);
    if (PH(2 + 4 * layer)) {
      if (PM & 4) for (int t0 = blockIdx.x; t0 < 2560 * ((DUP & 1) ? 2 : 1); t0 += gridDim.x) {
        const int t = t0 % 2560;
        int mi8, mt_, nt_;
        if (t < 1536) { mi8 = 1; mt_ = t % 32; nt_ = t / 32; }
        else if (t < 2048) { mi8 = 1; mt_ = 32 + ((t - 1536) % 16); nt_ = (t - 1536) / 16; }
        else { mi8 = 0; mt_ = 64 + ((t - 2048) % 32); nt_ = 32 + (t - 2048) / 32; }
        const bool gates = nt_ >= 24 && nt_ < 36;
        if (mi8) { if (gates) inproj_gates_tile<8>(p, layer, mt_, nt_, smem); else if (nt_ >= 36) inproj_attn_tile<8>(p, layer, mt_, nt_, smem); else inproj_tile<8>(p, layer, mt_, nt_, smem); }
        else { if (gates) inproj_gates_tile<4>(p, layer, mt_, nt_, smem); else if (nt_ >= 36) inproj_attn_tile<4>(p, layer, mt_, nt_, smem); else inproj_tile<4>(p, layer, mt_, nt_, smem); }
      }
    }
    GSYNC(3 + 4 * layer);
    if (PH(3 + 4 * layer)) { mixer_phase(p, layer, smem, s_item, layer, 15); if (DUP & 2) mixer_phase(p, layer, smem, s_item, 2 + layer, DMASK); }
    GSYNC(4 + 4 * layer);
    if (PH(4 + 4 * layer)) {
      if (PM & 128) for (int t0 = blockIdx.x; t0 < 1024 * ((DUP & 4) ? 2 : 1); t0 += gridDim.x) {
        const int t = t0 % 1024;
        if (t < 512) outproj_tile<8>(p, layer, t % 32, t / 32, smem);
        else outproj_tile<4>(p, layer, 64 + ((t - 512) % 32), (t - 512) / 32, smem);
      }
    }
    GSYNC(5 + 4 * layer);
    if (PH(5 + 4 * layer)) { if (PM & 256) ln_phase(p, layer); if (DUP & 8) ln_phase(p, layer); }
  }
}

extern "C" void kernel_launch(void* const* d_in, const int* in_sizes, int n_in, void* d_out, int out_size, void* d_ws,
                              size_t ws_size, hipStream_t stream) {
  static int grid_blocks = 0;
  if (!grid_blocks) {
    int dev = 0, cus = 0, per_cu = 0;
    hipGetDevice(&dev);
    hipDeviceGetAttribute(&cus, hipDeviceAttributeMultiprocessorCount, dev);
    hipOccupancyMaxActiveBlocksPerMultiprocessor(&per_cu, fwd_megakernel, 256, 0);
    if (per_cu < 1) per_cu = 1;
    if (per_cu > 2) per_cu = 2;
    grid_blocks = cus * per_cu;
  }
  Params p;
  memset(&p, 0, sizeof(p));
  const float** pf = (const float**)&p;
  for (int i = 0; i < 27; ++i) pf[i] = (const float*)d_in[i];
  p.out = (float*)d_out;
  unsigned char* ws = (unsigned char*)d_ws;
  size_t off = 0;
  auto take = [&](size_t bytes) { unsigned char* r = ws + off; off += (bytes + 255) & ~(size_t)255; return r; };
  p.ctr = (unsigned*)take(256);
  p.bar = (unsigned*)take(16384);
  p.mod = (float*)take((size_t)2 * 9 * 6144 * 4);
  p.WinT = (u16*)take((size_t)2 * NIN * 2048 * 2);
  p.WoutT = (u16*)take((size_t)2 * 2048 * 2048 * 2);
  p.WAbf = (u16*)take((size_t)2 * 2048 * 512 * 2);
  p.M2T = (u16*)take((size_t)2 * 1024 * 512 * 2);
  p.h2 = (float*)take((size_t)2 * 1280 * 64 * 4);
  p.FR = (u16*)take((size_t)2 * 2621440 * 2);
  p.DFT1024 = (u16*)take((size_t)1024 * 2048 * 2);
  p.DFT256 = (u16*)take((size_t)256 * 512 * 2);
  p.rope = (float*)take((size_t)1024 * 64 * 4);
  p.KL = (u16*)take((size_t)2 * 2 * 8 * 2 * 1280 * 64 * 2);
  p.VtL = (u16*)take((size_t)2 * 2 * 8 * 2 * 1280 * 64 * 2);
  p.KC = (u16*)take((size_t)2 * 16 * 2 * 256 * 64 * 2);
  p.VtC = (u16*)take((size_t)2 * 16 * 2 * 256 * 64 * 2);
  p.hmod = (u16*)take((size_t)NTOK * 2048 * 2);
  p.QB = (u16*)take((size_t)2 * NTOK * 512 * 2);
  p.R = (float*)(ws + off);
  p.G = (u16*)take((size_t)NTOK * 2048 * 2);
  p.UT = (u16*)take((size_t)NTOK * 1024 * 2);
  p.BT = (u16*)take((size_t)NTOK * 2048 * 2);
  if (off > ws_size) fprintf(stderr, "workspace too small: need %zu have %zu\n", off, ws_size);
  hipMemsetAsync(p.ctr, 0, 256 + 16384 + (size_t)2 * 9 * 6144 * 4, stream);
#if SINGLE_LAUNCH
  p.phase_lo = 0; p.phase_hi = NPHASE;
  void* args[] = {&p};
  hipError_t e = hipLaunchCooperativeKernel((void*)fwd_megakernel, dim3(grid_blocks), dim3(256), args, 0, stream);
  if (e != hipSuccess) fprintf(stderr, "cooperative launch failed: %s (grid %d)\n", hipGetErrorString(e), grid_blocks);
#else
  for (int ph = 0; ph < NPHASE; ++ph) {
    p.phase_lo = ph; p.phase_hi = ph + 1;
    fwd_megakernel<<<dim3(grid_blocks), dim3(256), 0, stream>>>(p);
  }
#endif
}
```

```cpp
#include <hip/hip_runtime.h>
#include <hip/hip_cooperative_groups.h>
#include <cstdio>
#include <cstring>
namespace cg = cooperative_groups;

#ifndef SINGLE_LAUNCH
#define SINGLE_LAUNCH 1
#endif
#ifndef DMASK
#define DMASK 15
#endif
#ifndef DUP
#define DUP 0
#endif
#ifndef PM
#define PM 0xffff
#endif

typedef __attribute__((ext_vector_type(8))) short bf16x8;
typedef __attribute__((ext_vector_type(4))) float f32x4;
typedef unsigned short u16;
typedef unsigned u32x4 __attribute__((ext_vector_type(4)));
typedef unsigned u32x2 __attribute__((ext_vector_type(2)));

#define NTOK 12288
#define NCTX 4096
#define DM 2048
#define NIN 6144
#define OUT_KV 25165824
#define KVSZ 1048576
#define NPHASE 10
#define MIX_ITEMS 2944

struct Params {
  const float *x_prompt, *x_sample, *cck, *ccv, *cdk, *cdv, *c, *c_ctx, *w_ada, *b_ada, *w_in, *w_f,
      *conv_w, *conv_b, *fw1, *fb1, *fw2, *fb2, *fw3, *log_decay, *skip, *sink, *q_norm, *k_norm,
      *w_out, *ln_g, *ln_b;
  float* out;
  u16 *WinT, *WoutT, *WAbf, *M2T, *FR, *DFT1024, *DFT256, *KL, *VtL, *KC, *VtC, *hmod, *G, *UT, *BT, *QB;
  float *mod, *h2, *rope, *R;
  unsigned* ctr;
  unsigned* bar;
  int phase_lo, phase_hi;
};

typedef __attribute__((ext_vector_type(2))) __bf16 bf16x2_t;
typedef __attribute__((ext_vector_type(2))) float f32x2_t;
__device__ __forceinline__ unsigned pack2(float a, float b) {
  const bf16x2_t v = __builtin_convertvector(f32x2_t{a, b}, bf16x2_t);
  return __builtin_bit_cast(unsigned, v);
}
__device__ __forceinline__ u16 f2bf(float f) {
  unsigned u = __float_as_uint(f);
  u += 0x7fffu + ((u >> 16) & 1u);
  return (u16)(u >> 16);
}
__device__ __forceinline__ float bf2f(u16 h) { return __uint_as_float(((unsigned)h) << 16); }
__device__ __forceinline__ float silu_f(float x) { return x / (1.0f + __expf(-x)); }
__device__ __forceinline__ float wave_sum(float v) {
#pragma unroll
  for (int o = 32; o > 0; o >>= 1) v += __shfl_xor(v, o);
  return v;
}
__device__ __forceinline__ int otid() { int t = threadIdx.x; asm volatile("" : "+v"(t)); return t; }
#define MFMA(a, b, c) __builtin_amdgcn_mfma_f32_16x16x32_bf16(a, b, c, 0, 0, 0)


#define XB_TMO      128
#define XB_XCNT(j)  (256  + 64 * (j))
#define XB_XSUB(j)  (1280 + 64 * (j))
#define XB_XGEN(j)  (2304 + 64 * (j))
#define XB_TOP      3328
#define XB_TOPGEN   3392
#define XCD_BAR_WORDS 3456
#define XB_SPIN_CAP (1u << 22)
#define LAS __attribute__((address_space(3)))
__device__ __forceinline__ unsigned xb_ld(unsigned* p) { return __hip_atomic_load(p, __ATOMIC_RELAXED, __HIP_MEMORY_SCOPE_AGENT); }
__device__ __forceinline__ unsigned xb_add(unsigned* p, unsigned v) { return __hip_atomic_fetch_add(p, v, __ATOMIC_RELAXED, __HIP_MEMORY_SCOPE_AGENT); }
__device__ __forceinline__ unsigned xb_xcc_id() { return (unsigned)__builtin_amdgcn_s_getreg((3 << 11) | 20) & 0xFu; }
#define XB_SPIN(cond, bar) do { unsigned _sp = 0; while (cond) { \
    if ((++_sp & 255u) == 0u) { if (xb_ld(&(bar)[XB_TMO])) break; if (_sp > XB_SPIN_CAP) { atomicAdd(&(bar)[XB_TMO], 1u); break; } } } } while (0)
struct XcdBarrier { unsigned* bar; unsigned x; volatile LAS unsigned* st; };
__device__ __forceinline__ XcdBarrier xcd_barrier_post(unsigned* bar, volatile LAS unsigned* st) {
  XcdBarrier b; b.bar = bar; b.x = xb_xcc_id(); b.st = st;
  if (threadIdx.x == 0) (void)xb_add(&bar[XB_XCNT(b.x)], 1u);
  return b;
}
__device__ __forceinline__ void xcd_barrier_complete(unsigned* bar, unsigned x, unsigned& nloc, unsigned& nx) {
  const unsigned G = gridDim.x * gridDim.y * gridDim.z;
  unsigned sum, cnt, mine, sp = 0u;
  for (;;) {
    sum = 0u; cnt = 0u; mine = 0u;
#pragma unroll
    for (unsigned j = 0; j < 16; ++j) { const unsigned c = xb_ld(&bar[XB_XCNT(j)]); sum += c; cnt += (c > 0u) ? 1u : 0u; mine = (j == x) ? c : mine; }
    if (sum == G) break;
    __builtin_amdgcn_s_sleep(1);
    if ((++sp & 255u) == 0u) { if (xb_ld(&bar[XB_TMO])) break; if (sp > XB_SPIN_CAP) { atomicAdd(&bar[XB_TMO], 1u); break; } }
  }
  nloc = mine > 0u ? mine : 1u; nx = cnt > 0u ? cnt : 1u;
}
__device__ __forceinline__ void xcd_barrier(const XcdBarrier& b) {
  asm volatile("s_waitcnt vmcnt(0)" ::: "memory");
  __syncthreads();
  if (threadIdx.x == 0) {
    unsigned* bar = b.bar;
    __builtin_amdgcn_s_waitcnt(0);
    unsigned nloc = b.st[0], nx = b.st[1];
    if (nloc == 0u) { xcd_barrier_complete(bar, b.x, nloc, nx); b.st[0] = nloc; b.st[1] = nx; }
    const unsigned old = xb_add(&bar[XB_XSUB(b.x)], 1u);
    const unsigned gen = old / nloc;
    if (old + 1u == (gen + 1u) * nloc) {
      __builtin_amdgcn_fence(__ATOMIC_RELEASE, "agent");
      asm volatile("s_waitcnt vmcnt(0)" ::: "memory");
      const unsigned og = xb_add(&bar[XB_TOP], 1u);
      const unsigned tg = og / nx;
      if (og + 1u == (tg + 1u) * nx) xb_add(&bar[XB_TOPGEN], 1u);
      else XB_SPIN(xb_ld(&bar[XB_TOPGEN]) == tg, bar);
      __builtin_amdgcn_fence(__ATOMIC_ACQUIRE, "agent");
      xb_add(&bar[XB_XGEN(b.x)], 1u);
      asm volatile("s_waitcnt vmcnt(0)" ::: "memory");
    } else {
      XB_SPIN(xb_ld(&bar[XB_XGEN(b.x)]) == gen, bar);
      __builtin_amdgcn_fence(__ATOMIC_ACQUIRE, "agent");
      asm volatile("s_waitcnt vmcnt(0)" ::: "memory");
    }
  }
  __syncthreads();
}

#ifndef GBK
#define GBK 64
#endif
#ifndef IMI
#define IMI 8
#endif
#define LDT GBK
#define ALDT 72
template <int MI>
__device__ __forceinline__ void gemm_core(const u16* __restrict__ A, int lda, const u16* __restrict__ Bt, int ldb,
                                          int K, u16* sA, u16* sB, f32x4 (&acc)[MI][4]) {
  constexpr int CPR = GBK / 8, RPP = 256 / CPR, NA = (32 * MI) / RPP, NB = 128 / RPP;
  const int tid = otid(), lane = tid & 63, wid = tid >> 6, wr = wid >> 1, wc = wid & 1;
  const int r16 = lane & 15, q = lane >> 4;
  const int lrow = tid / CPR, lck = (tid % CPR) * 8;
  u32x4 ra[NA], rb[NB];
  const u16* Ap = A + (size_t)lrow * lda + lck;
  const u16* Bp = Bt + (size_t)lrow * ldb + lck;
#pragma unroll
  for (int i = 0; i < NA; ++i) ra[i] = *(const u32x4*)(Ap + (size_t)i * RPP * lda);
#pragma unroll
  for (int i = 0; i < NB; ++i) rb[i] = *(const u32x4*)(Bp + (size_t)i * RPP * ldb);
  for (int k0 = 0; k0 < K; k0 += GBK) {
    __syncthreads();
#pragma unroll
    for (int i = 0; i < NA; ++i) *(u32x4*)(sA + (lrow + i * RPP) * LDT + (((tid % CPR) ^ (((lrow + i * RPP) >> 1) & 7)) * 8)) = ra[i];
#pragma unroll
    for (int i = 0; i < NB; ++i) *(u32x4*)(sB + (lrow + i * RPP) * LDT + (((tid % CPR) ^ (((lrow + i * RPP) >> 1) & 7)) * 8)) = rb[i];
    __syncthreads();
    if (k0 + GBK < K) {
#pragma unroll
      for (int i = 0; i < NA; ++i) ra[i] = *(const u32x4*)(Ap + (size_t)i * RPP * lda + k0 + GBK);
#pragma unroll
      for (int i = 0; i < NB; ++i) rb[i] = *(const u32x4*)(Bp + (size_t)i * RPP * ldb + k0 + GBK);
    }
    {
      const u16* sAw = sA + (wr * MI * 16 + r16) * LDT;
      const u16* sBw = sB + (wc * 64 + r16) * LDT;
      const int sw = r16 >> 1;
      constexpr int NS = (GBK / 32) * MI;
      constexpr int RD = (MI > 4) ? 2 : 3;
      bf16x8 bcur[4], bnext[4], ar[3];
#pragma unroll
      for (int ni = 0; ni < 4; ++ni) bcur[ni] = *(const bf16x8*)(sBw + ni * 16 * LDT + ((q ^ sw) * 8));
      ar[0] = *(const bf16x8*)(sAw + ((q ^ sw) * 8));
      if (RD > 2) ar[1] = *(const bf16x8*)(sAw + 16 * LDT + ((q ^ sw) * 8));
#pragma unroll
      for (int st = 0; st < NS; ++st) {
        const int ks = st / MI, mi = st % MI;
        if (st + RD - 1 < NS) {
          const int ks2 = (st + RD - 1) / MI, mi2 = (st + RD - 1) % MI;
          ar[(st + RD - 1) % RD] = *(const bf16x8*)(sAw + mi2 * 16 * LDT + (((ks2 * 4 + q) ^ sw) * 8));
        }
        if (mi == MI - 2 && ks + 1 < GBK / 32) {
#pragma unroll
          for (int ni = 0; ni < 4; ++ni) bnext[ni] = *(const bf16x8*)(sBw + ni * 16 * LDT + ((((ks + 1) * 4 + q) ^ sw) * 8));
        }
        __builtin_amdgcn_sched_barrier(0);
#pragma unroll
        for (int ni = 0; ni < 4; ++ni) acc[mi][ni] = MFMA(ar[st % RD], bcur[ni], acc[mi][ni]);
        __builtin_amdgcn_sched_barrier(0);
        if (mi == MI - 1 && ks + 1 < GBK / 32) {
#pragma unroll
          for (int ni = 0; ni < 4; ++ni) bcur[ni] = bnext[ni];
        }
      }
    }
  }
}

#define ZERO_ACC(acc)                                   \
  _Pragma("unroll") for (int _a = 0; _a < (int)(sizeof(acc) / sizeof(acc[0])); ++_a)      \
  _Pragma("unroll") for (int _b = 0; _b < 4; ++_b) acc[_a][_b] = f32x4{0.f, 0.f, 0.f, 0.f};

__device__ __forceinline__ void hmod_from_regs(const float (&v)[32], const float* __restrict__ modn, u16* __restrict__ outrow, int lane) {
  float s = 0.f;
#pragma unroll
  for (int i = 0; i < 32; ++i) s += v[i];
  const float mu = wave_sum(s) * (1.0f / 2048.0f);
  float s2 = 0.f;
#pragma unroll
  for (int i = 0; i < 32; ++i) { float d = v[i] - mu; s2 += d * d; }
  const float rstd = rsqrtf(wave_sum(s2) * (1.0f / 2048.0f) + 1e-5f);
#pragma unroll
  for (int i = 0; i < 8; ++i) {
    const int k = (i * 64 + lane) * 4;
    const float4 sh = *(const float4*)(modn + k);
    const float4 sc = *(const float4*)(modn + 2048 + k);
    float y0 = (v[i * 4 + 0] - mu) * rstd * (1.f + sc.x) + sh.x;
    float y1 = (v[i * 4 + 1] - mu) * rstd * (1.f + sc.y) + sh.y;
    float y2 = (v[i * 4 + 2] - mu) * rstd * (1.f + sc.z) + sh.z;
    float y3 = (v[i * 4 + 3] - mu) * rstd * (1.f + sc.w) + sh.w;
    u32x2 pk; pk.x = pack2(y0, y1); pk.y = pack2(y2, y3);
    *(u32x2*)(outrow + k) = pk;
  }
}

__device__ __forceinline__ int cond_of_row(int row) { return row < NCTX ? 0 : 1 + ((row - NCTX) >> 10); }

__device__ __forceinline__ int orig_col(int n) {
  if (n < 2560) return n;
  if (n < 3072) return 2560 + (n - 2560);
  if (n < 3584) return 512 + (n - 3072);
  if (n < 4096) return 3840 + (n - 3584);
  if (n < 4608) return 5120 + (n - 4096);
  if (n < 5120) return 3072 + (n - 4608);
  if (n < 5248) return 3584 + (n - 5120);
  if (n < 5376) return 3712 + (n - 5248);
  if (n < 5888) return 4352 + (n - 5376);
  if (n < 6016) return 4864 + (n - 5888);
  return 4992 + (n - 6016);
}

__device__ __forceinline__ void transpose_tile(const float* __restrict__ src, int lds_, u16* __restrict__ dst, int ldd, unsigned char* smem) {
  u16* tile = (u16*)smem;
  const int tid = otid();
  float v[32];
#pragma unroll
  for (int i = 0; i < 16; ++i) {
    const int kk = i * 4 + (tid >> 6), nn = tid & 63;
    v[i] = __builtin_nontemporal_load(&src[(size_t)kk * lds_ + nn]);
    v[16 + i] = __builtin_nontemporal_load(&src[(size_t)kk * lds_ + 64 + nn]);
  }
  __syncthreads();
#pragma unroll
  for (int i = 0; i < 16; ++i) {
    const int kk = i * 4 + (tid >> 6), nn = tid & 63;
    tile[kk * 66 + nn] = f2bf(v[i]);
    tile[64 * 66 + kk * 66 + nn] = f2bf(v[16 + i]);
  }
  __syncthreads();
#pragma unroll
  for (int i = 0; i < 16; ++i) {
    const int h = i >> 3, nn = (i & 7) * 8 + (tid >> 5), kk = (tid & 31) * 2;
    const unsigned pv = (unsigned)tile[h * 64 * 66 + kk * 66 + nn] | ((unsigned)tile[h * 64 * 66 + (kk + 1) * 66 + nn] << 16);
    *(unsigned*)(dst + (size_t)(h * 64 + nn) * ldd + kk) = pv;
  }
}

__device__ __forceinline__ void phase0(const Params& p, unsigned char* smem) {
  const int tid = otid(), lane = tid & 63, wid = tid >> 6;
  const int T_MOD = 768, T_TIN = 2560, T_TOUT = 1024, T_H2 = 640;
  const int total = T_MOD + T_TIN + T_TOUT + T_H2;
  for (int task = blockIdx.x; task < total; task += gridDim.x) {
    if (task < T_MOD) {
      const int kq = task & 3, t3 = task >> 2;
      const int l = t3 / 96, colc = (t3 % 96) * 64, col = colc + lane;
      const float* __restrict__ w = p.w_ada + (size_t)l * 2048 * 6144 + col;
      float acc[9];
#pragma unroll
      for (int n = 0; n < 9; ++n) acc[n] = 0.f;
      float* red = (float*)smem;
      float* tab = (float*)smem + 4 * 9 * 64;
      __syncthreads();
      for (int idx = tid; idx < 9 * 512; idx += 256) {
        const int n = idx >> 9, kk = idx & 511;
        const float cv = n == 0 ? p.c_ctx[kq * 512 + kk] : p.c[(n - 1) * 2048 + kq * 512 + kk];
        tab[idx] = silu_f(cv);
      }
      __syncthreads();
      const int kb = kq * 512 + wid * 128;
#pragma unroll 1
      for (int k32 = 0; k32 < 128; k32 += 32) {
        float wv[32];
#pragma unroll
        for (int e = 0; e < 32; ++e) wv[e] = __builtin_nontemporal_load(&w[(size_t)(kb + k32 + e) * 6144]);
#pragma unroll
        for (int e4 = 0; e4 < 32; e4 += 4) {
#pragma unroll
          for (int n = 0; n < 9; ++n) {
            const float4 tv = *(const float4*)(tab + n * 512 + wid * 128 + k32 + e4);
            acc[n] += tv.x * wv[e4] + tv.y * wv[e4 + 1] + tv.z * wv[e4 + 2] + tv.w * wv[e4 + 3];
          }
        }
      }
#pragma unroll
      for (int n = 0; n < 9; ++n) red[(wid * 9 + n) * 64 + lane] = acc[n];
      __syncthreads();
      for (int idx = tid; idx < 9 * 64; idx += 256) {
        const int n = idx >> 6, cc = idx & 63;
        float sres = red[(0 * 9 + n) * 64 + cc] + red[(1 * 9 + n) * 64 + cc] + red[(2 * 9 + n) * 64 + cc] + red[(3 * 9 + n) * 64 + cc];
        if (kq == 0) sres += p.b_ada[l * 6144 + colc + cc];
        atomicAdd(&p.mod[((size_t)l * 9 + n) * 6144 + colc + cc], sres);
      }
    } else if (task < T_MOD + T_TIN) {
      int t2 = task - T_MOD;
      const int l = t2 / 1280; t2 %= 1280;
      const int ntile = t2 / 32, ktile = t2 % 32;
      const int n0 = 1024 + ntile * 128, k0 = ktile * 64;
      const int oc = orig_col(n0);
      transpose_tile(p.w_in + ((size_t)l * 2048 + k0) * 5632 + oc, 5632, p.WinT + ((size_t)l * NIN + n0) * 2048 + k0, 2048, smem);
    } else if (task < T_MOD + T_TIN + T_TOUT) {
      int t2 = task - T_MOD - T_TIN;
      const int l = t2 / 512; t2 %= 512;
      const int ntile = t2 / 32, ktile = t2 % 32;
      transpose_tile(p.w_out + ((size_t)l * 2048 + ktile * 64) * 2048 + ntile * 128, 2048,
                     p.WoutT + ((size_t)l * 2048 + ntile * 128) * 2048 + ktile * 64, 2048, smem);
    } else {
      const int wt = (task - T_MOD - T_TIN - T_TOUT) * 4 + wid;
      const int l = wt / 1280, rem = wt % 1280;
      const int lenidx = rem < 256 ? 0 : 1;
      const int t = lenidx ? rem - 256 : rem;
      const float Lf = lenidx ? 1024.f : 256.f;
      const float tn = (float)t / Lf;
      const float* w1 = p.fw1 + l * 33 * 64;
      float h1 = p.fb1[l * 64 + lane] + tn * w1[lane];
      for (int f = 1; f <= 16; ++f) {
        float ang = 2.0f * 3.14159265358979323846f * tn * (float)f;
        h1 += cosf(ang) * w1[f * 64 + lane] + sinf(ang) * w1[(16 + f) * 64 + lane];
      }
      h1 = sinf(h1);
      const float* w2 = p.fw2 + l * 64 * 64;
      float h2v = p.fb2[l * 64 + lane];
      for (int i = 0; i < 64; ++i) h2v += __shfl(h1, i) * w2[i * 64 + lane];
      h2v = sinf(h2v);
      p.h2[((size_t)l * 1280 + (lenidx ? 256 : 0)) * 64 + (size_t)lane * (lenidx ? 1024 : 256) + t] = h2v;
    }
  }
  const size_t gtid = (size_t)blockIdx.x * 256 + tid, gstride = (size_t)gridDim.x * 256;
  {
    const float* __restrict__ win = p.w_in;
    u16* __restrict__ wab = p.WAbf;
#pragma unroll 4
    for (size_t idx = gtid; idx < (size_t)2 * 2048 * 128; idx += gstride) {
      const int l = (int)(idx >> 18), k = (int)((idx >> 7) & 2047), j4 = (int)(idx & 127) * 4;
      const f32x4 v4 = __builtin_nontemporal_load((const f32x4*)(win + ((size_t)l * 2048 + k) * 5632 + j4));
      u32x2 pk; pk.x = pack2(v4.x, v4.y); pk.y = pack2(v4.z, v4.w);
      *(u32x2*)(wab + ((size_t)l * 2048 + k) * 512 + j4) = pk;
    }
  }
  float* ctab = (float*)smem;
  __syncthreads();
  if (tid < 64) ctab[tid] = cosf((float)tid * (2.0f * 3.14159265358979323846f / 64.0f));
  __syncthreads();
  {
    const float* __restrict__ wfp = p.w_f;
    u16* __restrict__ m2t = p.M2T;
    for (size_t idx = gtid; idx < (size_t)2 * 512 * 512; idx += gstride) {
      const int l = (int)(idx >> 18), rem = (int)(idx & 262143);
      const int j = rem & 511, c = rem >> 9, g64 = j >> 6, jj = j & 63;
      const float* wf = wfp + ((size_t)l * 512 + g64 * 64) * 512 + c;
      float sc = 0.f, ss = 0.f;
#pragma unroll 16
      for (int i = 0; i < 64; ++i) {
        const int m = (jj * i) & 63;
        const float wv = wf[(size_t)i * 512];
        sc += ctab[m] * wv;
        ss += ctab[(m + 48) & 63] * wv;
      }
      m2t[((size_t)l * 1024 + c) * 512 + j] = f2bf(sc);
      m2t[((size_t)l * 1024 + 512 + c) * 512 + j] = f2bf(ss);
    }
  }
  for (size_t idx = gtid; idx < (size_t)1024 * 2048; idx += gstride) {
    int t = (int)(idx >> 11), sp = (int)(idx & 2047), s = sp & 1023;
    int m = (t * s) & 1023;
    float ang = (float)m * (2.0f * 3.14159265358979323846f / 1024.0f);
    float v = (sp < 1024 ? cosf(ang) : -sinf(ang)) * (1.0f / 256.0f);
    p.DFT1024[idx] = f2bf(v);
  }
  for (size_t idx = gtid; idx < (size_t)256 * 512; idx += gstride) {
    int t = (int)(idx >> 9), sp = (int)(idx & 511), s = sp & 255;
    int m = (t * s) & 255;
    float ang = (float)m * (2.0f * 3.14159265358979323846f / 256.0f);
    float v = (sp < 256 ? cosf(ang) : -sinf(ang)) * (1.0f / 128.0f);
    p.DFT256[idx] = f2bf(v);
  }
  for (size_t idx = gtid; idx < (size_t)1024 * 64; idx += gstride) {
    int t = (int)(idx >> 6), e = (int)(idx & 63), i = e >> 2, which = e & 3;
    float inv = powf(10000.0f, -(float)(2 * i) / 32.0f);
    float pos = (which < 2) ? (float)(t >> 6) : (float)(t & 63);
    float ang = pos * inv;
    p.rope[idx] = (which & 1) ? sinf(ang) : cosf(ang);
  }
  for (size_t idx = gtid; idx < (size_t)1048576; idx += gstride) {
    int d = (int)(idx & 63), kh = (int)((idx >> 6) & 1), pos = (int)((idx >> 7) & 255), b = (int)((idx >> 15) & 7);
    int br = (int)((idx >> 18) & 1), l = (int)(idx >> 19);
    size_t src = ((((size_t)b * 2 + l) * 256 + pos) * 2 + kh) * 64 + d;
    float kv = (br ? p.cdk : p.cck)[src];
    float vv = (br ? p.cdv : p.ccv)[src];
    size_t o = ((((size_t)l * 2 + br) * 8 + b) * 2 + kh);
    p.KL[(o * 1280 + 1024 + pos) * 64 + d] = f2bf(kv);
    p.VtL[(o * 64 + d) * 1280 + 1024 + pos] = f2bf(vv);
  }
}

__device__ __forceinline__ void filter_task(const Params& p, int ft, unsigned char* smem) {
  const int tid = otid(), lane = tid & 63, wid = tid >> 6;
  const int l = ft >> 9, rem = ft & 511, lenidx = rem >> 8, c2 = (rem & 255) * 4;
  const int L = lenidx ? 1024 : 256;
  const float* h2b = p.h2 + ((size_t)l * 1280 + (lenidx ? 256 : 0)) * 64;
  float* sw3 = (float*)smem;
  float* red = (float*)smem + 256;
  __syncthreads();
  { int j = tid >> 2, ch = tid & 3; sw3[tid] = p.fw3[((size_t)l * 64 + j) * 1024 + c2 + ch]; }
  __syncthreads();
  float decay[4];
#pragma unroll
  for (int ch = 0; ch < 4; ++ch) decay[ch] = expf(p.log_decay[l * 1024 + c2 + ch]);
  float hv[4][4];
  float ss[4] = {0.f, 0.f, 0.f, 0.f};
#pragma unroll
  for (int it = 0; it < 4; ++it) {
    const int t = tid + it * 256;
#pragma unroll
    for (int ch = 0; ch < 4; ++ch) hv[it][ch] = 0.f;
    if (t < L) {
      float d0 = 0.f, d1 = 0.f, d2 = 0.f, d3 = 0.f;
#pragma unroll
      for (int jq = 0; jq < 16; ++jq) {
        float4 hh;
        hh.x = h2b[(size_t)(jq * 4 + 0) * L + t]; hh.y = h2b[(size_t)(jq * 4 + 1) * L + t];
        hh.z = h2b[(size_t)(jq * 4 + 2) * L + t]; hh.w = h2b[(size_t)(jq * 4 + 3) * L + t];
        const float* wp = sw3 + jq * 16;
        d0 += hh.x * wp[0] + hh.y * wp[4] + hh.z * wp[8] + hh.w * wp[12];
        d1 += hh.x * wp[1] + hh.y * wp[5] + hh.z * wp[9] + hh.w * wp[13];
        d2 += hh.x * wp[2] + hh.y * wp[6] + hh.z * wp[10] + hh.w * wp[14];
        d3 += hh.x * wp[3] + hh.y * wp[7] + hh.z * wp[11] + hh.w * wp[15];
      }
      const float dist = fabsf((float)t - (float)(L / 2)) / (float)(L / 2);
      hv[it][0] = d0 * (expf(-dist * decay[0]) + 0.05f);
      hv[it][1] = d1 * (expf(-dist * decay[1]) + 0.05f);
      hv[it][2] = d2 * (expf(-dist * decay[2]) + 0.05f);
      hv[it][3] = d3 * (expf(-dist * decay[3]) + 0.05f);
#pragma unroll
      for (int ch = 0; ch < 4; ++ch) ss[ch] += hv[it][ch] * hv[it][ch];
    }
  }
#pragma unroll
  for (int ch = 0; ch < 4; ++ch) ss[ch] = wave_sum(ss[ch]);
  if (lane == 0) {
#pragma unroll
    for (int ch = 0; ch < 4; ++ch) red[wid * 4 + ch] = ss[ch];
  }
  __syncthreads();
  float rs[4];
#pragma unroll
  for (int ch = 0; ch < 4; ++ch) rs[ch] = rsqrtf(red[ch] + red[4 + ch] + red[8 + ch] + red[12 + ch] + 1e-6f);
  u16* FRb = p.FR + (size_t)l * 2621440 + (lenidx ? 1024 * 512 : 0) + (size_t)c2 * 2 * L;
#pragma unroll
  for (int it = 0; it < 4; ++it) {
    const int t = tid + it * 256;
    if (t < L) {
      const int ip = 3 * L / 2 - 1 - t;
#pragma unroll
      for (int ch = 0; ch < 4; ++ch) FRb[(size_t)ch * 2 * L + ip] = f2bf(hv[it][ch] * rs[ch]);
    }
  }
  for (int i = tid; i < L; i += 256) {
    const int ip = i < L / 2 ? i : i + L;
#pragma unroll
    for (int ch = 0; ch < 4; ++ch) FRb[(size_t)ch * 2 * L + ip] = 0;
  }
}

__device__ __forceinline__ void hmod_rows_task(const Params& p, int layer, int row, int lane) {
  const float* xr = row < NCTX ? p.x_prompt + (size_t)row * DM : p.x_sample + (size_t)(row - NCTX) * DM;
  float v[32];
#pragma unroll
  for (int i = 0; i < 8; ++i) {
    const f32x4 t4 = __builtin_nontemporal_load((const f32x4*)(xr + (i * 64 + lane) * 4));
    v[i * 4 + 0] = t4.x; v[i * 4 + 1] = t4.y; v[i * 4 + 2] = t4.z; v[i * 4 + 3] = t4.w;
  }
  hmod_from_regs(v, p.mod + ((size_t)layer * 9 + cond_of_row(row)) * 6144, p.hmod + (size_t)row * DM, lane);
}

__device__ __forceinline__ void phase1(const Params& p, unsigned char* smem) {
  const int tid = otid(), lane = tid & 63, wid = tid >> 6, wr = wid >> 1, wc = wid & 1, r16 = lane & 15, q = lane >> 4;
  const int total = 256 + 1024 + 3072;
  for (int task = blockIdx.x; task < total; task += gridDim.x) {
    if (task < 256) {
      const int l = task >> 7, rem = task & 127, mt = rem >> 4, nt = rem & 15;
      f32x4 acc[4][4];
      ZERO_ACC(acc);
      gemm_core<4>(p.M2T + ((size_t)l * 1024 + mt * 128) * 512, 512, p.WAbf + ((size_t)l * 2048 + nt * 128) * 512, 512, 512,
                (u16*)smem, (u16*)smem + 128 * LDT, acc);
      u16* dst = p.WinT + (size_t)l * NIN * 2048;
#pragma unroll
      for (int mi = 0; mi < 4; ++mi)
#pragma unroll
        for (int ni = 0; ni < 4; ++ni)
#pragma unroll
          for (int j = 0; j < 4; ++j) {
            int row = mt * 128 + wr * 64 + mi * 16 + q * 4 + j, col = nt * 128 + wc * 64 + ni * 16 + r16;
            dst[(size_t)row * 2048 + col] = f2bf(acc[mi][ni][j]);
          }
    } else if (task < 1280) {
      filter_task(p, task - 256, smem);
    } else {
      hmod_rows_task(p, 0, (task - 1280) * 4 + wid, lane);
    }
  }
}


template <int MIA>
__device__ __forceinline__ void wave_store_rows(const f32x4 (&a)[MIA][4], float scale, u16* wl, u16* dst, size_t ld, int lane) {
  u16* wb = wl + ((lane >> 4) * 4) * 72 + (lane & 15);
#pragma unroll
  for (int mi = 0; mi < 4; ++mi)
#pragma unroll
    for (int ni = 0; ni < 4; ++ni)
    {
      const unsigned p01 = pack2(a[mi][ni][0] * scale, a[mi][ni][1] * scale);
      const unsigned p23 = pack2(a[mi][ni][2] * scale, a[mi][ni][3] * scale);
      wb[(mi * 16 + 0) * 72 + ni * 16] = (u16)p01;
      wb[(mi * 16 + 1) * 72 + ni * 16] = (u16)(p01 >> 16);
      wb[(mi * 16 + 2) * 72 + ni * 16] = (u16)p23;
      wb[(mi * 16 + 3) * 72 + ni * 16] = (u16)(p23 >> 16);
    }
  __builtin_amdgcn_sched_barrier(0);
  const u16* rp = wl + (lane >> 3) * 72 + (lane & 7) * 8;
  u16* gp = dst + (size_t)(lane >> 3) * ld + (lane & 7) * 8;
#pragma unroll
  for (int it = 0; it < 8; it += 2) {
    const u32x4 v0 = *(const u32x4*)(rp + it * 8 * 72);
    const u32x4 v1 = *(const u32x4*)(rp + (it + 1) * 8 * 72);
    *(u32x4*)(gp + (size_t)(it * 8) * ld) = v0;
    *(u32x4*)(gp + (size_t)((it + 1) * 8) * ld) = v1;
    __builtin_amdgcn_sched_barrier(0);
  }
}

__device__ __forceinline__ void wave_store_rows_gated(const f32x4 (&a)[4][4], u16* wl, u16* dst, const u16* gsrc, size_t ld, int lane) {
  u16* wb = wl + ((lane >> 4) * 4) * 72 + (lane & 15);
#pragma unroll
  for (int mi = 0; mi < 4; ++mi)
#pragma unroll
    for (int ni = 0; ni < 4; ++ni) {
      const unsigned p01 = pack2(a[mi][ni][0], a[mi][ni][1]);
      const unsigned p23 = pack2(a[mi][ni][2], a[mi][ni][3]);
      wb[(mi * 16 + 0) * 72 + ni * 16] = (u16)p01;
      wb[(mi * 16 + 1) * 72 + ni * 16] = (u16)(p01 >> 16);
      wb[(mi * 16 + 2) * 72 + ni * 16] = (u16)p23;
      wb[(mi * 16 + 3) * 72 + ni * 16] = (u16)(p23 >> 16);
    }
  __builtin_amdgcn_sched_barrier(0);
  const u16* rp = wl + (lane >> 3) * 72 + (lane & 7) * 8;
  const size_t goff = (size_t)(lane >> 3) * ld + (lane & 7) * 8;
#pragma unroll
  for (int it = 0; it < 8; ++it) {
    const u32x4 v = *(const u32x4*)(rp + it * 8 * 72);
    const u32x4 gq = __builtin_nontemporal_load((const u32x4*)(gsrc + goff + (size_t)(it * 8) * ld));
    u32x4 o;
    o.x = pack2(__uint_as_float(v.x << 16) * silu_f(__uint_as_float(gq.x << 16)), __uint_as_float(v.x & 0xffff0000u) * silu_f(__uint_as_float(gq.x & 0xffff0000u)));
    o.y = pack2(__uint_as_float(v.y << 16) * silu_f(__uint_as_float(gq.y << 16)), __uint_as_float(v.y & 0xffff0000u) * silu_f(__uint_as_float(gq.y & 0xffff0000u)));
    o.z = pack2(__uint_as_float(v.z << 16) * silu_f(__uint_as_float(gq.z << 16)), __uint_as_float(v.z & 0xffff0000u) * silu_f(__uint_as_float(gq.z & 0xffff0000u)));
    o.w = pack2(__uint_as_float(v.w << 16) * silu_f(__uint_as_float(gq.w << 16)), __uint_as_float(v.w & 0xffff0000u) * silu_f(__uint_as_float(gq.w & 0xffff0000u)));
    *(u32x4*)(dst + goff + (size_t)(it * 8) * ld) = o;
  }
}
template <int MI>
__device__ __forceinline__ void inproj_tile(const Params& p, int layer, int mt, int nt, unsigned char* smem) {
  f32x4 acc[MI][4];
  ZERO_ACC(acc);
  gemm_core<MI>(p.hmod + (size_t)(mt * (MI * 32)) * DM, DM, p.WinT + ((size_t)layer * NIN + nt * 128) * 2048, 2048, 2048,
            (u16*)smem, (u16*)smem + (MI * 32) * LDT, acc);
  const int tid = otid(), lane = tid & 63, wid = tid >> 6, wr = wid >> 1, wc = wid & 1, r16 = lane & 15, g = lane >> 4;
  const int row0 = mt * (MI * 32), col0 = nt * 128;
  const bool isctx = row0 < NCTX;
  const int b = isctx ? (row0 >> 8) : ((row0 - NCTX) >> 10);
  const int L = isctx ? 256 : 1024;
  const int twb = (isctx ? (row0 & 255) : ((row0 - NCTX) & 1023)) + wr * (MI * 16);
  const int wcol = col0 + wc * 64;
#pragma unroll 1
  for (int mh = 0; mh < MI / 4; ++mh) {
  const int tw0 = twb + mh * 64;
  if (col0 < 3072) {
#pragma unroll
    for (int ni = 0; ni < 4; ++ni) {
      const int cp = wcol + ni * 16 + r16;
      u16* base;
      if (col0 < 1024) {
        const int half = cp >> 9, c = cp & 511;
        base = p.UT + (isctx ? (size_t)0 : (size_t)16 * 1024 * 256) + (((size_t)(b * 512 + c)) * 2 + half) * L;
      } else {
        const int cc = cp - 1024;
        base = p.BT + (isctx ? (size_t)0 : (size_t)16 * 2048 * 256) + ((size_t)(b * 2048 + cc)) * L;
      }
#pragma unroll
      for (int mi = 0; mi < 4; ++mi) {
        const int t = tw0 + mi * 16 + g * 4;
        u32x2 pk; pk.x = pack2(acc[mi][ni][0], acc[mi][ni][1]); pk.y = pack2(acc[mi][ni][2], acc[mi][ni][3]);
        *(u32x2*)(base + t) = pk;
      }
    }
  }
  if (MI > 4) {
#pragma unroll
    for (int mi = 0; mi < 4; ++mi)
#pragma unroll
      for (int ni = 0; ni < 4; ++ni) acc[mi][ni] = acc[(MI > 4 ? 4 : 0) + mi][ni];
  }
  }
}


template <int MI>
__device__ __forceinline__ void inproj_attn_tile(const Params& p, int layer, int mt, int nt, unsigned char* smem) {
  f32x4 acc[MI][4];
  ZERO_ACC(acc);
  gemm_core<MI>(p.hmod + (size_t)(mt * (MI * 32)) * DM, DM, p.WinT + ((size_t)layer * NIN + nt * 128) * 2048, 2048, 2048,
            (u16*)smem, (u16*)smem + (MI * 32) * LDT, acc);
  const int tid = otid(), lane = tid & 63, wid = tid >> 6, wr = wid >> 1, wc = wid & 1, r16 = lane & 15, g = lane >> 4;
  const int row0 = mt * (MI * 32), col0 = nt * 128;
  __syncthreads();
  u16* wl = (u16*)smem + wid * (64 * 72);
  const bool isctx = row0 < NCTX;
  const int b = isctx ? (row0 >> 8) : ((row0 - NCTX) >> 10);
  const int L = isctx ? 256 : 1024;
  const int twb = (isctx ? (row0 & 255) : ((row0 - NCTX) & 1023)) + wr * (MI * 16);
  const int wcol = col0 + wc * 64;
#pragma unroll 1
  for (int mh = 0; mh < MI / 4; ++mh) {
  const int tw0 = twb + mh * 64;
  {
    const int a = wcol - 4608;
    const int br = a >= 768 ? 1 : 0;
    const int a2 = a - br * 768;
    const int kind = a2 < 512 ? 0 : (a2 < 640 ? 1 : 2);
    const int hh = kind == 0 ? (a2 >> 6) : (kind == 1 ? ((a2 - 512) >> 6) : ((a2 - 640) >> 6));
    if (kind < 2) {
      if (br == 1) {
        const float* gn = (kind == 0 ? p.q_norm : p.k_norm) + layer * 64;
        float gw[4];
#pragma unroll
        for (int ni = 0; ni < 4; ++ni) gw[ni] = gn[ni * 16 + r16];
#pragma unroll
        for (int mi = 0; mi < 4; ++mi)
#pragma unroll
          for (int j = 0; j < 4; ++j) {
            float ss = 0.f;
#pragma unroll
            for (int ni = 0; ni < 4; ++ni) ss += acc[mi][ni][j] * acc[mi][ni][j];
            ss += __shfl_xor(ss, 1); ss += __shfl_xor(ss, 2); ss += __shfl_xor(ss, 4); ss += __shfl_xor(ss, 8);
            const float rstd = rsqrtf(ss * (1.0f / 64.0f) + 1e-6f);
#pragma unroll
            for (int ni = 0; ni < 4; ++ni) acc[mi][ni][j] *= rstd * gw[ni];
          }
      }
      if (kind == 1 && isctx) {
        float* ob = p.out + OUT_KV + (size_t)br * 2 * KVSZ;
#pragma unroll
        for (int mi = 0; mi < 4; ++mi)
#pragma unroll
          for (int j = 0; j < 4; ++j) {
            const int t = tw0 + mi * 16 + g * 4 + j;
#pragma unroll
            for (int ni = 0; ni < 4; ++ni)
              __builtin_nontemporal_store(acc[mi][ni][j], &ob[((((size_t)b * 2 + layer) * 256 + t) * 2 + hh) * 64 + ni * 16 + r16]);
          }
      }
      if (!isctx) {
#pragma unroll
        for (int mi = 0; mi < 4; ++mi) {
          __builtin_amdgcn_sched_barrier(0);
#pragma unroll
          for (int j = 0; j < 4; ++j) {
            const int t = tw0 + mi * 16 + g * 4 + j;
            const float4 rc4 = *(const float4*)(p.rope + (size_t)t * 64 + r16 * 4);
            const float cr = rc4.x, sr = rc4.y, cc = rc4.z, sc = rc4.w;
            const float x1 = acc[mi][0][j], x2 = acc[mi][1][j];
            acc[mi][0][j] = x1 * cr - x2 * sr; acc[mi][1][j] = x2 * cr + x1 * sr;
            const float y1 = acc[mi][2][j], y2 = acc[mi][3][j];
            acc[mi][2][j] = y1 * cc - y2 * sc; acc[mi][3][j] = y2 * cc + y1 * sc;
          }
        }
      }
      if (kind == 0) {
        u16* qb = p.QB + (size_t)br * NTOK * 512;
        wave_store_rows<MI>(acc, 0.125f * 1.4426950408889634f, wl, qb + (size_t)(row0 + wr * (MI * 16) + mh * 64) * 512 + hh * 64, 512, lane);
      } else {
        u16* kb;
        if (isctx) kb = p.KC + ((((size_t)br * 16 + b) * 2 + hh) * 256) * 64;
        else kb = p.KL + (((((size_t)layer * 2 + br) * 8 + b) * 2 + hh) * 1280) * 64;
        wave_store_rows<MI>(acc, 1.0f, wl, kb + (size_t)tw0 * 64, 64, lane);
      }
    } else {
      if (isctx) {
        float* ob = p.out + OUT_KV + KVSZ + (size_t)br * 2 * KVSZ;
#pragma unroll
        for (int mi = 0; mi < 4; ++mi)
#pragma unroll
          for (int j = 0; j < 4; ++j) {
            const int t = tw0 + mi * 16 + g * 4 + j;
#pragma unroll
            for (int ni = 0; ni < 4; ++ni)
              __builtin_nontemporal_store(acc[mi][ni][j], &ob[((((size_t)b * 2 + layer) * 256 + t) * 2 + hh) * 64 + ni * 16 + r16]);
          }
      }
      u16* vb; int ldv;
      if (isctx) { vb = p.VtC + ((((size_t)br * 16 + b) * 2 + hh) * 64) * 256; ldv = 256; }
      else { vb = p.VtL + (((((size_t)layer * 2 + br) * 8 + b) * 2 + hh) * 64) * 1280; ldv = 1280; }
#pragma unroll
      for (int ni = 0; ni < 4; ++ni) {
        const int d = ni * 16 + r16;
#pragma unroll
        for (int mi = 0; mi < 4; ++mi) {
          const int t = tw0 + mi * 16 + g * 4;
          u32x2 pk; pk.x = pack2(acc[mi][ni][0], acc[mi][ni][1]); pk.y = pack2(acc[mi][ni][2], acc[mi][ni][3]);
          *(u32x2*)(vb + (size_t)d * ldv + t) = pk;
        }
      }
    }
  }
  if (MI > 4) {
#pragma unroll
    for (int mi = 0; mi < 4; ++mi)
#pragma unroll
      for (int ni = 0; ni < 4; ++ni) acc[mi][ni] = acc[(MI > 4 ? 4 : 0) + mi][ni];
  }
  }
}


template <int MI>
__device__ __forceinline__ void inproj_gates_tile(const Params& p, int layer, int mt, int nt, unsigned char* smem) {
  f32x4 acc[MI][4];
  ZERO_ACC(acc);
  gemm_core<MI>(p.hmod + (size_t)(mt * (MI * 32)) * DM, DM, p.WinT + ((size_t)layer * NIN + nt * 128) * 2048, 2048, 2048,
                (u16*)smem, (u16*)smem + (MI * 32) * LDT, acc);
  const int tid = otid(), lane = tid & 63, wid = tid >> 6, wr = wid >> 1, wc = wid & 1;
  const int row0 = mt * (MI * 32), col0 = nt * 128, wcol = col0 + wc * 64;
  __syncthreads();
  u16* wl = (u16*)smem + wid * (64 * 72);
  u16* dstb = p.G + (size_t)(row0 + wr * (MI * 16)) * 2048 + (col0 < 3584 ? wcol - 3072 : wcol - 2560);
#pragma unroll 1
  for (int mh = 0; mh < MI / 4; ++mh) {
    wave_store_rows<MI>(acc, 1.0f, wl, dstb + (size_t)mh * 64 * 2048, 2048, lane);
    if (MI > 4) {
#pragma unroll
      for (int mi = 0; mi < 4; ++mi)
#pragma unroll
        for (int ni = 0; ni < 4; ++ni) acc[mi][ni] = acc[(MI > 4 ? 4 : 0) + mi][ni];
    }
  }
}

__device__ __forceinline__ void fourier_tile(const Params& p, int path, int mt, int nt, unsigned char* smem) {
  const int tid = otid(), lane = tid & 63, wid = tid >> 6, wr = wid >> 1, wc = wid & 1, r16 = lane & 15, g = lane >> 4;
  const int L = path ? 1024 : 256;
  const u16* A = (path ? p.DFT1024 : p.DFT256) + (size_t)mt * 128 * 2 * L;
  const u16* Bt = p.UT + (path ? (size_t)16 * 1024 * 256 : (size_t)0) + (size_t)nt * 128 * 2 * L;
  f32x4 acc[4][4];
  ZERO_ACC(acc);
  gemm_core<4>(A, 2 * L, Bt, 2 * L, 2 * L, (u16*)smem, (u16*)smem + 128 * LDT, acc);
  const int b = nt >> 2, c0 = (nt & 3) * 128;
  const int rowbase = (path ? NCTX + b * 1024 : b * 256) + mt * 128 + wr * 64;
  __syncthreads();
  wave_store_rows_gated(acc, (u16*)smem + wid * (64 * 72), p.hmod + (size_t)rowbase * 2048 + c0 + wc * 64,
                        p.G + (size_t)rowbase * 2048 + c0 + wc * 64, 2048, lane);
}

__device__ __forceinline__ float conv3_at(const u16* __restrict__ rowp, int t, int L, float w0, float w1, float w2, float bias) {
  float u0 = t > 0 ? bf2f(rowp[t - 1]) : 0.f;
  float u1 = bf2f(rowp[t]);
  float u2 = t < L - 1 ? bf2f(rowp[t + 1]) : 0.f;
  return u0 * w0 + u1 * w1 + u2 * w2 + bias;
}


__device__ __forceinline__ void conv3_x4(const u16* __restrict__ rowp, int t, int L, float w0, float w1, float w2, float bias, float (&out)[4]) {
  const u32x2 r4 = *(const u32x2*)(rowp + t);
  float u[6];
  u[0] = t > 0 ? bf2f(rowp[t - 1]) : 0.f;
  u[5] = t + 4 < L ? bf2f(rowp[t + 4]) : 0.f;
  u[1] = __uint_as_float(r4.x << 16); u[2] = __uint_as_float(r4.x & 0xffff0000u);
  u[3] = __uint_as_float(r4.y << 16); u[4] = __uint_as_float(r4.y & 0xffff0000u);
#pragma unroll
  for (int j = 0; j < 4; ++j) out[j] = u[j] * w0 + u[j + 1] * w1 + u[j + 2] * w2 + bias;
}

template <int L>
__device__ __forceinline__ void filter_vec_load(const u16* __restrict__ Gf, int tid, u32x4& a, u32x4& b) {
  constexpr int NV = 2 * L / 8;
  a = u32x4{0u, 0u, 0u, 0u}; b = u32x4{0u, 0u, 0u, 0u};
  if (tid < NV) {
    a = __builtin_nontemporal_load((const u32x4*)(Gf + tid * 8));
    if (tid + 1 < NV) b = __builtin_nontemporal_load((const u32x4*)(Gf + tid * 8 + 8));
  }
}
template <int L>
__device__ __forceinline__ void filter_copies_store(const u32x4& a, const u32x4& b, unsigned char* smem, int tid) {
  constexpr int FS = 2 * L * 2 + 32;
  constexpr int NV = 2 * L / 8;
  if (tid < NV) {
    const unsigned w[8] = {a.x, a.y, a.z, a.w, b.x, b.y, b.z, b.w};
#pragma unroll
    for (int m = 0; m < 8; ++m) {
      u32x4 o;
      if (m & 1) {
        o.x = (w[0 + m / 2] >> 16) | (w[1 + m / 2] << 16);
        o.y = (w[1 + m / 2] >> 16) | (w[2 + m / 2] << 16);
        o.z = (w[2 + m / 2] >> 16) | (w[3 + m / 2] << 16);
        o.w = (w[3 + m / 2] >> 16) | (w[4 + m / 2] << 16);
      } else {
        o.x = w[0 + m / 2]; o.y = w[1 + m / 2]; o.z = w[2 + m / 2]; o.w = w[3 + m / 2];
      }
      *(u32x4*)(smem + m * FS + tid * 16) = o;
    }
  }
}
template <int NT>
__device__ __forceinline__ void row_prefetch(const u16* __restrict__ rowp, int tb, int tlo, int thi, int L, u32x2 (&r)[NT], float& elo, float& ehi) {
#pragma unroll
  for (int i = 0; i < NT; ++i) r[i] = *(const u32x2*)(rowp + tb + i * 16);
  elo = tlo >= 0 ? bf2f(rowp[tlo >= 0 ? tlo : 0]) : 0.f;
  ehi = thi < L ? bf2f(rowp[thi < L ? thi : 0]) : 0.f;
}
template <int NT>
__device__ __forceinline__ void conv3_pref(const u32x2 (&r)[NT], int i, int lane, int g, float elo, float ehi, float w0, float w1, float w2,
                                           float bias, float (&out)[4]) {
  const unsigned upv = (unsigned)__shfl((int)r[i].y, lane - 16);
  const unsigned up0 = (unsigned)__shfl((int)r[i > 0 ? i - 1 : 0].y, lane + 48);
  const unsigned dnv = (unsigned)__shfl((int)r[i].x, lane + 16);
  const unsigned dn3 = (unsigned)__shfl((int)r[i + 1 < NT ? i + 1 : NT - 1].x, lane - 48);
  float u[6];
  u[0] = g > 0 ? __uint_as_float(upv & 0xffff0000u) : (i > 0 ? __uint_as_float(up0 & 0xffff0000u) : elo);
  u[5] = g < 3 ? __uint_as_float(dnv << 16) : (i + 1 < NT ? __uint_as_float(dn3 << 16) : ehi);
  u[1] = __uint_as_float(r[i].x << 16); u[2] = __uint_as_float(r[i].x & 0xffff0000u);
  u[3] = __uint_as_float(r[i].y << 16); u[4] = __uint_as_float(r[i].y & 0xffff0000u);
#pragma unroll
  for (int j = 0; j < 4; ++j) out[j] = u[j] * w0 + u[j + 1] * w1 + u[j + 2] * w2 + bias;
}

template <int L, int NB>
__device__ __forceinline__ void hyena_item(const Params& p, int layer, int c, unsigned char* smem) {
  constexpr int NT = L / 64;
  constexpr int FS = 2 * L * 2 + 32;
  constexpr int VS = L * 2 + 16;
  constexpr int VOFF = 8 * (4096 + 32);
  constexpr int path = (L == 1024) ? 1 : 0;
  const int tid = otid(), lane = tid & 63, w = tid >> 6, r16 = lane & 15, g = lane >> 4;
  const u16* raw = p.BT + (path ? (size_t)16 * 2048 * 256 : (size_t)0);
  const float* cw = p.conv_w + (size_t)layer * 3 * 1536;
  const float* cb = p.conv_b + (size_t)layer * 1536;
  const u16* FRb = p.FR + (size_t)layer * 2621440 + (path ? 1024 * 512 : 0);
  unsigned char* vbuf = smem + VOFF;
  const int wv = __builtin_amdgcn_readfirstlane(w);
  const int bl = r16 & (NB - 1);
  const int tb = wv * NT * 16 + g * 4;
  const int tlo = wv * NT * 16 - 1, thi = (wv + 1) * NT * 16;

  u32x4 fa1, fb1, fa2, fb2;
  filter_vec_load<L>(FRb + (size_t)c * 2 * L, tid, fa1, fb1);
  filter_vec_load<L>(FRb + (size_t)(512 + c) * 2 * L, tid, fa2, fb2);
  u32x2 r1[NT];
  float e1lo, e1hi;
  row_prefetch<NT>(raw + ((size_t)(bl * 2048 + 512 + c)) * L, tb, tlo, thi, L, r1, e1lo, e1hi);
  {
    const float w0 = cw[c], w1 = cw[1536 + c], w2 = cw[3072 + c], bias = cb[c];
#pragma unroll
    for (int it = 0; it < NB * L / 8 / 256; ++it) {
      const int vi = tid + it * 256;
      const int b = vi / (L / 8), s8 = (vi % (L / 8)) * 8;
      const u16* rowp = raw + ((size_t)(b * 2048 + c)) * L;
      const u32x4 rv = *(const u32x4*)(rowp + s8);
      float u[10];
      u[0] = s8 > 0 ? bf2f(rowp[s8 > 0 ? s8 - 1 : 0]) : 0.f;
      u[9] = s8 + 8 < L ? bf2f(rowp[s8 + 8 < L ? s8 + 8 : 0]) : 0.f;
      u[1] = __uint_as_float(rv.x << 16); u[2] = __uint_as_float(rv.x & 0xffff0000u);
      u[3] = __uint_as_float(rv.y << 16); u[4] = __uint_as_float(rv.y & 0xffff0000u);
      u[5] = __uint_as_float(rv.z << 16); u[6] = __uint_as_float(rv.z & 0xffff0000u);
      u[7] = __uint_as_float(rv.w << 16); u[8] = __uint_as_float(rv.w & 0xffff0000u);
      float o[8];
#pragma unroll
      for (int e = 0; e < 8; ++e) o[e] = u[e] * w0 + u[e + 1] * w1 + u[e + 2] * w2 + bias;
      u32x4 pk; pk.x = pack2(o[0], o[1]); pk.y = pack2(o[2], o[3]); pk.z = pack2(o[4], o[5]); pk.w = pack2(o[6], o[7]);
      *(u32x4*)(vbuf + b * VS + s8 * 2) = pk;
    }
  }
  filter_copies_store<L>(fa1, fb1, smem, tid);
  __syncthreads();

  const int idxb = 8 * g - (wv * NT) * 16 - r16 + L - 1;
  const int mcp = idxb & 7;
  const unsigned char* abase = smem + mcp * FS + (idxb - mcp) * 2;
  const unsigned char* bbase = vbuf + bl * VS + g * 16;
  f32x4 acc[NT];
#pragma unroll
  for (int i = 0; i < NT; ++i) acc[i] = f32x4{0.f, 0.f, 0.f, 0.f};
  {
    bf16x8 ring[NT];
#pragma unroll
    for (int i = 0; i < NT; ++i) ring[(NT - i) % NT] = *(const bf16x8*)(abase - i * 32);
    for (int st0 = 0; st0 < L / 32; st0 += NT / 2) {
#pragma unroll
      for (int u = 0; u < NT / 2; ++u) {
        const int st = st0 + u;
        const bf16x8 bfr = *(const bf16x8*)(bbase + st * 64);
        ring[(2 * u) % NT] = *(const bf16x8*)(abase + st * 64);
        ring[(2 * u - 1 + NT) % NT] = *(const bf16x8*)(abase + st * 64 - 32);
#pragma unroll
        for (int i = NT - 1; i >= 0; --i) acc[i] = MFMA(ring[(2 * u - i + 2 * NT) % NT], bfr, acc[i]);
      }
    }
  }
  __syncthreads();
  {
    const float w0 = cw[512 + c], w1 = cw[1536 + 512 + c], w2 = cw[3072 + 512 + c], bias = cb[512 + c];
    const float sk = p.skip[layer * 1024 + c];
#pragma unroll
    for (int i = 0; i < NT; ++i) {
      float x1[4];
      conv3_pref<NT>(r1, i, lane, g, e1lo, e1hi, w0, w1, w2, bias, x1);
      if (r16 < NB) {
        u32x2* vp = (u32x2*)(vbuf + bl * VS + (tb + i * 16) * 2);
        const u32x2 vv = *vp;
        float z[4];
        z[0] = x1[0] * (acc[i][0] + sk * __uint_as_float(vv.x << 16));
        z[1] = x1[1] * (acc[i][1] + sk * __uint_as_float(vv.x & 0xffff0000u));
        z[2] = x1[2] * (acc[i][2] + sk * __uint_as_float(vv.y << 16));
        z[3] = x1[3] * (acc[i][3] + sk * __uint_as_float(vv.y & 0xffff0000u));
        u32x2 pk; pk.x = pack2(z[0], z[1]); pk.y = pack2(z[2], z[3]);
        *vp = pk;
      }
    }
  }
  u32x2 r2[NT], rg[NT];
  float e2lo, e2hi, dmy0, dmy1;
  row_prefetch<NT>(raw + ((size_t)(bl * 2048 + 1024 + c)) * L, tb, tlo, thi, L, r2, e2lo, e2hi);
  row_prefetch<NT>(raw + ((size_t)(bl * 2048 + 1536 + c)) * L, tb, -1, L, L, rg, dmy0, dmy1);
  filter_copies_store<L>(fa2, fb2, smem, tid);
  __syncthreads();
#pragma unroll
  for (int i = 0; i < NT; ++i) acc[i] = f32x4{0.f, 0.f, 0.f, 0.f};
  {
    bf16x8 ring[NT];
#pragma unroll
    for (int i = 0; i < NT; ++i) ring[(NT - i) % NT] = *(const bf16x8*)(abase - i * 32);
    for (int st0 = 0; st0 < L / 32; st0 += NT / 2) {
#pragma unroll
      for (int u = 0; u < NT / 2; ++u) {
        const int st = st0 + u;
        const bf16x8 bfr = *(const bf16x8*)(bbase + st * 64);
        ring[(2 * u) % NT] = *(const bf16x8*)(abase + st * 64);
        ring[(2 * u - 1 + NT) % NT] = *(const bf16x8*)(abase + st * 64 - 32);
#pragma unroll
        for (int i = NT - 1; i >= 0; --i) acc[i] = MFMA(ring[(2 * u - i + 2 * NT) % NT], bfr, acc[i]);
      }
    }
  }
  {
    const float w0 = cw[1024 + c], w1 = cw[1536 + 1024 + c], w2 = cw[3072 + 1024 + c], bias = cb[1024 + c];
    const float sk = p.skip[layer * 1024 + 512 + c];
    const int rowbase = path ? NCTX + bl * 1024 : bl * 256;
#pragma unroll
    for (int i = 0; i < NT; ++i) {
      float x2v[4];
      conv3_pref<NT>(r2, i, lane, g, e2lo, e2hi, w0, w1, w2, bias, x2v);
      if (r16 < NB) {
        const int t = tb + i * 16;
        const u32x2 vv = *(const u32x2*)(vbuf + bl * VS + t * 2);
        float zz[4], gt[4];
        zz[0] = __uint_as_float(vv.x << 16); zz[1] = __uint_as_float(vv.x & 0xffff0000u);
        zz[2] = __uint_as_float(vv.y << 16); zz[3] = __uint_as_float(vv.y & 0xffff0000u);
        gt[0] = __uint_as_float(rg[i].x << 16); gt[1] = __uint_as_float(rg[i].x & 0xffff0000u);
        gt[2] = __uint_as_float(rg[i].y << 16); gt[3] = __uint_as_float(rg[i].y & 0xffff0000u);
#pragma unroll
        for (int j = 0; j < 4; ++j) {
          const float val = x2v[j] * (acc[i][j] + sk * zz[j]);
          const size_t row = (size_t)(rowbase + t + j);
          p.hmod[row * 2048 + 512 + c] = f2bf(val * silu_f(gt[j]));
        }
      }
    }
  }
}

__device__ __forceinline__ void attn_item(const Params& p, int layer, int path, int br, int b, int h, int qb, unsigned char* smem) {
  const int tid = otid(), lane = tid & 63, w = tid >> 6, r16 = lane & 15, g = lane >> 4;
  const int rowbase = path ? NCTX + b * 1024 : b * 256;
  const int kh = h >> 2;
  const u16* Kb; const u16* Vb; int ldv;
  if (path) { size_t o = ((((size_t)layer * 2 + br) * 8 + b) * 2 + kh); Kb = p.KL + o * 1280 * 64; Vb = p.VtL + o * 64 * 1280; ldv = 1280; }
  else { size_t o = (((size_t)br * 16 + b) * 2 + kh); Kb = p.KC + o * 256 * 64; Vb = p.VtC + o * 64 * 256; ldv = 256; }
  constexpr int VLD = 136;
  u16* sK = (u16*)smem;
  u16* sV = (u16*)smem + 128 * 64;
  bf16x8 qf[2][2];
  const u16* Qb = p.QB + (size_t)br * NTOK * 512;
#pragma unroll
  for (int qt = 0; qt < 2; ++qt)
#pragma unroll
    for (int ks = 0; ks < 2; ++ks) {
      const int qrow = rowbase + qb * 128 + w * 32 + qt * 16 + r16;
      qf[qt][ks] = *(const bf16x8*)(Qb + (size_t)qrow * 512 + h * 64 + ks * 32 + g * 8);
    }
  float m[2], ls[2];
  f32x4 o[4][2];
#pragma unroll
  for (int dt = 0; dt < 4; ++dt)
#pragma unroll
    for (int qt = 0; qt < 2; ++qt) o[dt][qt] = f32x4{0.f, 0.f, 0.f, 0.f};
  if (br == 0) { const float sk = p.sink[layer * 8 + h] * 1.4426950408889634f;   m[0] = m[1] = sk; ls[0] = ls[1] = (g == 0) ? 1.f : 0.f; }
  else { m[0] = m[1] = -1e30f; ls[0] = ls[1] = 0.f; }
  int ntiles, wlo = 0;
  const bool windowed = (path == 1 && br == 0);
  if (!path) ntiles = 2;
  else if (br == 1) ntiles = 10;
  else { wlo = max(0, qb - 1); const int whi = min(8, qb + 2); ntiles = 2 + whi - wlo; }
  auto kstart_of = [&](int i) -> int {
    if (!windowed) return i * 128;
    return i < 2 ? 1024 + i * 128 : (wlo + i - 2) * 128;
  };
  const int lrow = tid >> 3, lck = (tid & 7) * 8;
  u32x4 rk[4], rv[4];
  const int vrow = tid >> 4, vck = (tid & 15) * 8;
  {
    const int ks0 = kstart_of(0);
#pragma unroll
    for (int j = 0; j < 4; ++j) {
      rk[j] = *(const u32x4*)(Kb + (size_t)(ks0 + lrow + j * 32) * 64 + lck);
      rv[j] = *(const u32x4*)(Vb + (size_t)(vrow + j * 16) * ldv + ks0 + vck);
    }
  }
  for (int it = 0; it < ntiles; ++it) {
    const int kst = kstart_of(it);
    __syncthreads();
#pragma unroll
    for (int j = 0; j < 4; ++j) {
      *(u32x4*)(sK + (lrow + j * 32) * 64 + (((tid & 7) ^ (((lrow + j * 32) >> 1) & 7)) * 8)) = rk[j];
      *(u32x4*)(sV + (vrow + j * 16) * VLD + vck) = rv[j];
    }
    __syncthreads();
    if (it + 1 < ntiles) {
      const int ks1 = kstart_of(it + 1);
#pragma unroll
      for (int j = 0; j < 4; ++j) {
        rk[j] = *(const u32x4*)(Kb + (size_t)(ks1 + lrow + j * 32) * 64 + lck);
        rv[j] = *(const u32x4*)(Vb + (size_t)(vrow + j * 16) * ldv + ks1 + vck);
      }
    }
    f32x4 s[8][2];
#pragma unroll
    for (int kk = 0; kk < 8; ++kk) {
      const bf16x8 kf0 = *(const bf16x8*)(sK + (kk * 16 + r16) * 64 + ((g ^ (r16 >> 1)) * 8));
      const bf16x8 kf1 = *(const bf16x8*)(sK + (kk * 16 + r16) * 64 + (((4 + g) ^ (r16 >> 1)) * 8));
#pragma unroll
      for (int qt = 0; qt < 2; ++qt) {
        f32x4 z = f32x4{0.f, 0.f, 0.f, 0.f};
        z = MFMA(kf0, qf[qt][0], z);
        s[kk][qt] = MFMA(kf1, qf[qt][1], z);
      }
    }
    const int q0w = qb * 128 + __builtin_amdgcn_readfirstlane(w) * 32;
    if (windowed && it >= 2 && (kst + 127 - q0w > 128 || q0w + 31 - kst > 128)) {
      asm volatile("" ::: "memory");
#pragma unroll
      for (int kk = 0; kk < 8; ++kk)
#pragma unroll
        for (int qt = 0; qt < 2; ++qt)
#pragma unroll
          for (int j = 0; j < 4; ++j) {
            const int kpos = kst + kk * 16 + g * 4 + j;
            const int qpos = qb * 128 + w * 32 + qt * 16 + r16;
            const int df = kpos - qpos;
            if (df > 128 || df < -128) s[kk][qt][j] = -1e30f;
          }
    }
#pragma unroll
    for (int qt = 0; qt < 2; ++qt) {
      float mx = -1e30f;
#pragma unroll
      for (int kk = 0; kk < 8; ++kk)
#pragma unroll
        for (int j = 0; j < 4; ++j) mx = fmaxf(mx, s[kk][qt][j]);
      mx = fmaxf(mx, __shfl_xor(mx, 16));
      mx = fmaxf(mx, __shfl_xor(mx, 32));
      const float mnew = fmaxf(m[qt], mx);
      const float alpha = __builtin_amdgcn_exp2f(m[qt] - mnew);
      m[qt] = mnew;
      float psum = 0.f;
#pragma unroll
      for (int kk = 0; kk < 8; ++kk)
#pragma unroll
        for (int j = 0; j < 4; ++j) {
          const float pv = __builtin_amdgcn_exp2f(s[kk][qt][j] - mnew);
          psum += pv;
          s[kk][qt][j] = pv;
        }
      ls[qt] = ls[qt] * alpha + psum;
#pragma unroll
      for (int dt = 0; dt < 4; ++dt) {
        o[dt][qt][0] *= alpha; o[dt][qt][1] *= alpha; o[dt][qt][2] *= alpha; o[dt][qt][3] *= alpha;
      }
    }
#pragma unroll
    for (int c = 0; c < 4; ++c) {
      bf16x8 pf[2];
#pragma unroll
      for (int qt = 0; qt < 2; ++qt) {
        u32x4 cvt;
        cvt.x = pack2(s[2 * c][qt][0], s[2 * c][qt][1]);
        cvt.y = pack2(s[2 * c][qt][2], s[2 * c][qt][3]);
        cvt.z = pack2(s[2 * c + 1][qt][0], s[2 * c + 1][qt][1]);
        cvt.w = pack2(s[2 * c + 1][qt][2], s[2 * c + 1][qt][3]);
        pf[qt] = __builtin_bit_cast(bf16x8, cvt);
      }
#pragma unroll
      for (int dt = 0; dt < 4; ++dt) {
        const u32x2 vlo = *(const u32x2*)(sV + (dt * 16 + r16) * VLD + c * 32 + g * 4);
        const u32x2 vhi = *(const u32x2*)(sV + (dt * 16 + r16) * VLD + c * 32 + 16 + g * 4);
        u32x4 vv4; vv4.x = vlo.x; vv4.y = vlo.y; vv4.z = vhi.x; vv4.w = vhi.y;
        const bf16x8 vfv = __builtin_bit_cast(bf16x8, vv4);
#pragma unroll
        for (int qt = 0; qt < 2; ++qt) o[dt][qt] = MFMA(vfv, pf[qt], o[dt][qt]);
      }
    }
  }
  const int gcol = 1024 + br * 512 + h * 64;
#pragma unroll
  for (int qt = 0; qt < 2; ++qt) {
    float lt = ls[qt];
    lt += __shfl_xor(lt, 16);
    lt += __shfl_xor(lt, 32);
    const float inv = 1.0f / lt;
    const size_t row = (size_t)(rowbase + qb * 128 + w * 32 + qt * 16 + r16);
#pragma unroll
    for (int dt = 0; dt < 4; ++dt) {
      const int d = dt * 16 + g * 4;
      const u32x2 gg = *(const u32x2*)(p.G + row * 2048 + gcol + d);
      const float g0 = bf2f((u16)(gg.x & 0xffff)), g1 = bf2f((u16)(gg.x >> 16)), g2 = bf2f((u16)(gg.y & 0xffff)), g3 = bf2f((u16)(gg.y >> 16));
      u32x2 pk;
      pk.x = pack2(o[dt][qt][0] * inv * silu_f(g0), o[dt][qt][1] * inv * silu_f(g1));
      pk.y = pack2(o[dt][qt][2] * inv * silu_f(g2), o[dt][qt][3] * inv * silu_f(g3));
      *(u32x2*)(p.hmod + row * 2048 + gcol + d) = pk;
    }
  }
}

__device__ __forceinline__ void mixer_phase(const Params& p, int layer, unsigned char* smem, int* s_item, int cidx, int tmask) {
  bool first_round = true;
  for (;;) {
    __syncthreads();
    if (threadIdx.x == 0) *s_item = first_round ? (int)blockIdx.x : (int)(atomicAdd(p.ctr + cidx, 1u) + gridDim.x);
    first_round = false;
    __syncthreads();
    const int item = __builtin_amdgcn_readfirstlane(*s_item);
    if (item >= MIX_ITEMS) break;
    int type, a0 = 0, a1 = 0, a2 = 0, a3 = 0, a4 = 0;
    if (item < 512) { type = 0; a0 = 1; a1 = 1; a2 = item >> 6; a3 = (item >> 3) & 7; a4 = item & 7; }
    else if (item < 768) { const int i2 = item - 512; type = 1; a0 = 1; a1 = i2 & 7; a2 = i2 >> 3; }
    else if (item < 1280) { type = 2; a0 = item - 768; }
    else if (item < 1792) { const int i4 = item - 1280; type = 0; a0 = 1; a1 = 0; a2 = i4 >> 6; a3 = (i4 >> 3) & 7; a4 = i4 & 7; }
    else if (item < 2304) { const int i5 = item - 1792; type = 0; a0 = 0; a1 = i5 >> 8; a2 = (i5 >> 4) & 15; a3 = (i5 >> 1) & 7; a4 = i5 & 1; }
    else if (item < 2432) { const int i6 = item - 2304; type = 1; a0 = 0; a1 = i6 & 1; a2 = i6 >> 1; }
    else { type = 3; a0 = item - 2432; }
    if (!((tmask >> type) & 1)) continue;
    if (type >= 2 && cidx < 2) {
      if (threadIdx.x == 0) {
        const unsigned x0 = xb_xcc_id() & 7u;
        unsigned* hc = p.ctr + 8 + (layer * 2 + (type - 2)) * 8;
        int ch = a0;
        for (unsigned tr = 0; tr < 8u; ++tr) {
          const unsigned xx = (x0 + tr) & 7u;
          const unsigned idx = atomicAdd(hc + xx, 1u);
          if (idx < 64u) { ch = (int)(xx * 64u + idx); break; }
        }
        s_item[1] = ch;
      }
      __syncthreads();
      a0 = __builtin_amdgcn_readfirstlane(s_item[1]);
    }
    if (type == 0) { if (PM & 8) attn_item(p, layer, a0, a1, a2, a3, a4, smem); }
    else if (type == 1) { if (PM & 16) fourier_tile(p, a0, a1, a2, smem); }
    else if (type == 2) { if (PM & 32) hyena_item<1024, 8>(p, layer, a0, smem); }
    else { if (PM & 64) hyena_item<256, 16>(p, layer, a0, smem); }
  }
}

template <int MI>
__device__ __forceinline__ void outproj_tile(const Params& p, int layer, int mt, int nt, unsigned char* smem) {
  const int tid = otid(), lane = tid & 63, wid = tid >> 6, wr = wid >> 1, wc = wid & 1, r16 = lane & 15, g = lane >> 4;
  const int row0 = mt * (MI * 32), col0 = nt * 128;
  f32x4 acc[MI][4];
  ZERO_ACC(acc);
  gemm_core<MI>(p.hmod + (size_t)row0 * DM, DM, p.WoutT + ((size_t)layer * 2048 + col0) * 2048, 2048, 2048,
            (u16*)smem, (u16*)smem + (MI * 32) * LDT, acc);
  const float* gatep = p.mod + ((size_t)layer * 9 + cond_of_row(row0)) * 6144 + 4096;
  u16* Y = (u16*)p.R;
  float gt[4];
#pragma unroll
  for (int ni = 0; ni < 4; ++ni) gt[ni] = gatep[col0 + wc * 64 + ni * 16 + r16];
  __syncthreads();
  u16* wl = (u16*)smem + wid * (64 * 72);
#pragma unroll 1
  for (int mh = 0; mh < MI / 4; ++mh) {
#pragma unroll
    for (int mi = 0; mi < 4; ++mi)
#pragma unroll
      for (int ni = 0; ni < 4; ++ni) {
        acc[mi][ni][0] *= gt[ni]; acc[mi][ni][1] *= gt[ni]; acc[mi][ni][2] *= gt[ni]; acc[mi][ni][3] *= gt[ni];
      }
    wave_store_rows<MI>(acc, 1.0f, wl, Y + (size_t)(row0 + wr * (MI * 16) + mh * 64) * DM + col0 + wc * 64, DM, lane);
    if (MI > 4) {
#pragma unroll
      for (int mi = 0; mi < 4; ++mi)
#pragma unroll
        for (int ni = 0; ni < 4; ++ni) acc[mi][ni] = acc[(MI > 4 ? 4 : 0) + mi][ni];
    }
  }
}

__device__ __forceinline__ void ln_phase(const Params& p, int layer) {
  const int tid = otid(), lane = tid & 63, wid = tid >> 6;
  const float* lg = p.ln_g + layer * DM;
  const float* lb = p.ln_b + layer * DM;
  for (int task = blockIdx.x; task < NTOK / 4; task += gridDim.x) {
    const int row = task * 4 + wid;
    const u16* yy = (const u16*)p.R + (size_t)row * DM;
    const float* xr = layer == 0 ? (row < NCTX ? p.x_prompt + (size_t)row * DM : p.x_sample + (size_t)(row - NCTX) * DM)
                                 : p.out + (size_t)row * DM;
    const float ALPHA = 1.41421356237309515f;
    float v[32];
#pragma unroll
    for (int i = 0; i < 8; ++i) {
      const f32x4 t4 = __builtin_nontemporal_load((const f32x4*)(xr + (i * 64 + lane) * 4));
      const u32x2 h4 = __builtin_nontemporal_load((const u32x2*)(yy + (i * 64 + lane) * 4));
      v[i * 4 + 0] = ALPHA * t4.x + __uint_as_float(h4.x << 16);
      v[i * 4 + 1] = ALPHA * t4.y + __uint_as_float(h4.x & 0xffff0000u);
      v[i * 4 + 2] = ALPHA * t4.z + __uint_as_float(h4.y << 16);
      v[i * 4 + 3] = ALPHA * t4.w + __uint_as_float(h4.y & 0xffff0000u);
    }
    float s = 0.f;
#pragma unroll
    for (int i = 0; i < 32; ++i) s += v[i];
    const float mu = wave_sum(s) * (1.0f / 2048.0f);
    float s2 = 0.f;
#pragma unroll
    for (int i = 0; i < 32; ++i) { float d = v[i] - mu; s2 += d * d; }
    const float rstd = rsqrtf(wave_sum(s2) * (1.0f / 2048.0f) + 1e-5f);
    float* orow = p.out + (size_t)row * DM;
#pragma unroll
    for (int i = 0; i < 8; ++i) {
      const int k = (i * 64 + lane) * 4;
      const float4 g4 = *(const float4*)(lg + k);
      const float4 b4 = *(const float4*)(lb + k);
      float4 y;
      y.x = (v[i * 4 + 0] - mu) * rstd * g4.x + b4.x;
      y.y = (v[i * 4 + 1] - mu) * rstd * g4.y + b4.y;
      y.z = (v[i * 4 + 2] - mu) * rstd * g4.z + b4.z;
      y.w = (v[i * 4 + 3] - mu) * rstd * g4.w + b4.w;
      __builtin_nontemporal_store(f32x4{y.x, y.y, y.z, y.w}, (f32x4*)(orow + k));
      v[i * 4 + 0] = y.x; v[i * 4 + 1] = y.y; v[i * 4 + 2] = y.z; v[i * 4 + 3] = y.w;
    }
    if (layer == 0) hmod_from_regs(v, p.mod + ((size_t)1 * 9 + cond_of_row(row)) * 6144, p.hmod + (size_t)row * DM, lane);
  }
}

__global__ void __launch_bounds__(256, 2) fwd_megakernel(Params p) {
  __shared__ __attribute__((aligned(16))) unsigned char smem[(IMI * 32 + 128) * LDT * 2 > 49536 ? (IMI * 32 + 128) * LDT * 2 : 49536];
  __shared__ int s_item[2];
  cg::grid_group grid = cg::this_grid();
  __shared__ u32x4 xb_words;
  if (threadIdx.x == 0) xb_words = u32x4{0u, 0u, 0u, 0u};
  __syncthreads();
  XcdBarrier xb = xcd_barrier_post(p.bar, (volatile LAS unsigned*)&xb_words);
  if (p.phase_hi > 1000) grid.sync();
#define PH(n) (p.phase_lo <= (n) && (n) < p.phase_hi)
#define GSYNC(n) if (p.phase_lo < (n) && (n) < p.phase_hi) { xcd_barrier(xb); if (DUP & 64) { xcd_barrier(xb); xcd_barrier(xb); } }
  if (PH(0)) { if (PM & 1) phase0(p, smem); if (DUP & 16) phase0(p, smem); }
  GSYNC(1);
  if (PH(1)) { if (PM & 2) phase1(p, smem); if (DUP & 32) phase1(p, smem); }
  for (int layer = 0; layer < 2; ++layer) {
    GSYNC(2 + 4 * layer);
    if (PH(2 + 4 * layer)) {
      if (PM & 4) for (int t0 = blockIdx.x; t0 < 2560 * ((DUP & 1) ? 2 : 1); t0 += gridDim.x) {
        const int t = t0 % 2560;
        int mi8, mt_, nt_;
        if (t < 1536) { mi8 = 1; mt_ = t % 32; nt_ = t / 32; }
        else if (t < 2048) { mi8 = 1; mt_ = 32 + ((t - 1536) % 16); nt_ = (t - 1536) / 16; }
        else { mi8 = 0; mt_ = 64 + ((t - 2048) % 32); nt_ = 32 + (t - 2048) / 32; }
        const bool gates = nt_ >= 24 && nt_ < 36;
        if (mi8) { if (gates) inproj_gates_tile<8>(p, layer, mt_, nt_, smem); else if (nt_ >= 36) inproj_attn_tile<8>(p, layer, mt_, nt_, smem); else inproj_tile<8>(p, layer, mt_, nt_, smem); }
        else { if (gates) inproj_gates_tile<4>(p, layer, mt_, nt_, smem); else if (nt_ >= 36) inproj_attn_tile<4>(p, layer, mt_, nt_, smem); else inproj_tile<4>(p, layer, mt_, nt_, smem); }
      }
    }
    GSYNC(3 + 4 * layer);
    if (PH(3 + 4 * layer)) { mixer_phase(p, layer, smem, s_item, layer, 15); if (DUP & 2) mixer_phase(p, layer, smem, s_item, 2 + layer, DMASK); }
    GSYNC(4 + 4 * layer);
    if (PH(4 + 4 * layer)) {
      if (PM & 128) for (int t0 = blockIdx.x; t0 < 1024 * ((DUP & 4) ? 2 : 1); t0 += gridDim.x) {
        const int t = t0 % 1024;
        if (t < 512) outproj_tile<8>(p, layer, t % 32, t / 32, smem);
        else outproj_tile<4>(p, layer, 64 + ((t - 512) % 32), (t - 512) / 32, smem);
      }
    }
    GSYNC(5 + 4 * layer);
    if (PH(5 + 4 * layer)) { if (PM & 256) ln_phase(p, layer); if (DUP & 8) ln_phase(p, layer); }
  }
}

extern "C" void kernel_launch(void* const* d_in, const int* in_sizes, int n_in, void* d_out, int out_size, void* d_ws,
                              size_t ws_size, hipStream_t stream) {
  static int grid_blocks = 0;
  if (!grid_blocks) {
    int dev = 0, cus = 0, per_cu = 0;
    hipGetDevice(&dev);
    hipDeviceGetAttribute(&cus, hipDeviceAttributeMultiprocessorCount, dev);
    hipOccupancyMaxActiveBlocksPerMultiprocessor(&per_cu, fwd_megakernel, 256, 0);
    if (per_cu < 1) per_cu = 1;
    if (per_cu > 2) per_cu = 2;
    grid_blocks = cus * per_cu;
  }
  Params p;
  memset(&p, 0, sizeof(p));
  const float** pf = (const float**)&p;
  for (int i = 0; i < 27; ++i) pf[i] = (const float*)d_in[i];
  p.out = (float*)d_out;
  unsigned char* ws = (unsigned char*)d_ws;
  size_t off = 0;
  auto take = [&](size_t bytes) { unsigned char* r = ws + off; off += (bytes + 255) & ~(size_t)255; return r; };
  p.ctr = (unsigned*)take(256);
  p.bar = (unsigned*)take(16384);
  p.mod = (float*)take((size_t)2 * 9 * 6144 * 4);
  p.WinT = (u16*)take((size_t)2 * NIN * 2048 * 2);
  p.WoutT = (u16*)take((size_t)2 * 2048 * 2048 * 2);
  p.WAbf = (u16*)take((size_t)2 * 2048 * 512 * 2);
  p.M2T = (u16*)take((size_t)2 * 1024 * 512 * 2);
  p.h2 = (float*)take((size_t)2 * 1280 * 64 * 4);
  p.FR = (u16*)take((size_t)2 * 2621440 * 2);
  p.DFT1024 = (u16*)take((size_t)1024 * 2048 * 2);
  p.DFT256 = (u16*)take((size_t)256 * 512 * 2);
  p.rope = (float*)take((size_t)1024 * 64 * 4);
  p.KL = (u16*)take((size_t)2 * 2 * 8 * 2 * 1280 * 64 * 2);
  p.VtL = (u16*)take((size_t)2 * 2 * 8 * 2 * 1280 * 64 * 2);
  p.KC = (u16*)take((size_t)2 * 16 * 2 * 256 * 64 * 2);
  p.VtC = (u16*)take((size_t)2 * 16 * 2 * 256 * 64 * 2);
  p.hmod = (u16*)take((size_t)NTOK * 2048 * 2);
  p.QB = (u16*)take((size_t)2 * NTOK * 512 * 2);
  p.R = (float*)(ws + off);
  p.G = (u16*)take((size_t)NTOK * 2048 * 2);
  p.UT = (u16*)take((size_t)NTOK * 1024 * 2);
  p.BT = (u16*)take((size_t)NTOK * 2048 * 2);
  if (off > ws_size) fprintf(stderr, "workspace too small: need %zu have %zu\n", off, ws_size);
  hipMemsetAsync(p.ctr, 0, 256 + 16384 + (size_t)2 * 9 * 6144 * 4, stream);
#if SINGLE_LAUNCH
  p.phase_lo = 0; p.phase_hi = NPHASE;
  void* args[] = {&p};
  hipError_t e = hipLaunchCooperativeKernel((void*)fwd_megakernel, dim3(grid_blocks), dim3(256), args, 0, stream);
  if (e != hipSuccess) fprintf(stderr, "cooperative launch failed: %s (grid %d)\n", hipGetErrorString(e), grid_blocks);
#else
  for (int ph = 0; ph < NPHASE; ++ph) {
    p.phase_lo = ph; p.phase_hi = ph + 1;
    fwd_megakernel<<<dim3(grid_blocks), dim3(256), 0, stream>>>(p);
  }
#endif
}
```
